# Optimizing an MI355X kernel written in HIP

```python
import numpy as np
import jax
import jax.numpy as jnp
from jax import lax

D_MODEL = 1024
BATCH = 16
SEQ = 2048
DEPTH = 1

GRID_W = 64
CTX_LEN = 256
N_MOD = 6
EPS = 1e-6

RW_HEAD_DIM = 64
RW_HEADS = (D_MODEL // 2) // RW_HEAD_DIM
RW_WIDTH = RW_HEADS * RW_HEAD_DIM
RW_DECAY_LORA = 64
RW_AAA_LORA = 64
RW_GATE_LORA = 128
RW_GN_EPS = 1e-5 * RW_HEAD_DIM
CONV_K = 3

HG_KEY_DIM = 64
HG_VAL_DIM = 64
HG_HEADS = (D_MODEL // 2) // HG_VAL_DIM
HG_KWIDTH = HG_HEADS * HG_KEY_DIM
HG_VWIDTH = HG_HEADS * HG_VAL_DIM
HG_CHUNK = 32

D_MIX = RW_WIDTH + HG_VWIDTH
IN_SPLITS = (RW_WIDTH, RW_WIDTH, RW_WIDTH, 2 * RW_DECAY_LORA, 2 * RW_AAA_LORA, RW_GATE_LORA,
             HG_KWIDTH, HG_KWIDTH, HG_KWIDTH, HG_VWIDTH, HG_VWIDTH)
P_IN = sum(IN_SPLITS)

N_EXPERTS = 64
N_GROUPS = 8
TOPK_GROUPS = 4
TOP_K = 8
D_EXPERT = D_MODEL // 4
D_SHARED = D_MODEL // 4
ROUTE_SCALE = 2.5
MOE_BLOCK = 256

kernel_name = 'hybrid_rwkv7_hgrn2_moe_dit_layer'


def _rmsnorm(x, g):
    xf = x.astype(jnp.float32)
    y = xf * lax.rsqrt(jnp.mean(xf * xf, axis=-1, keepdims=True) + EPS)
    return (y * g.astype(jnp.float32)).astype(x.dtype)


def _split_cols(u):
    idx = [int(i) for i in np.cumsum(IN_SPLITS)[:-1]]
    return jnp.split(u, idx, axis=-1)


def _heads(t, h, d):
    return t.reshape(t.shape[0], t.shape[1], h, d).astype(jnp.float32)


def _conv_latent(u, kern, rows):
    b, l, ch = u.shape
    u2 = u.reshape(b, rows, GRID_W, ch)
    out = lax.conv_general_dilated(u2, kern[:, :, None, :].astype(u.dtype), window_strides=(1, 1),
                                   padding='SAME', dimension_numbers=('NHWC', 'HWIO', 'NHWC'),
                                   feature_group_count=ch)
    return out.reshape(b, l, ch)


def _conv_context(u, kern):
    ch = u.shape[-1]
    return lax.conv_general_dilated(u, kern[CONV_K // 2][:, None, :].astype(u.dtype), window_strides=(1,),
                                    padding='SAME', dimension_numbers=('NWC', 'WIO', 'NWC'),
                                    feature_group_count=ch)


def _rwkv7_scan(r, w, k, v, a, b, s0, reverse, emit):
    def step(s, inp):
        r_t, w_t, k_t, v_t, a_t, b_t = inp
        sa = jnp.einsum('bhvk,bhk->bhv', s, a_t)
        s = s * w_t[:, :, None, :] + sa[..., None] * b_t[:, :, None, :] + v_t[..., None] * k_t[:, :, None, :]
        y = jnp.einsum('bhvk,bhk->bhv', s, r_t) if emit else None
        return s, y
    xs = tuple(jnp.moveaxis(t, 1, 0) for t in (r, w, k, v, a, b))
    s_fin, ys = lax.scan(step, s0, xs, reverse=reverse)
    return (jnp.moveaxis(ys, 0, 1) if emit else None), s_fin


def _rwkv7_mix(cols, conv_fn, s0, w0, w2, a0, a2, g2, k_k, k_a, r_k, lnx_g, lnx_b, emit):
    r, k, v, wd, ad, gd = cols
    r, k, v = jnp.split(conv_fn(jnp.concatenate([r, k, v], axis=-1)), 3, axis=-1)
    bsz, l, _ = r.shape
    rh = _heads(r, RW_HEADS, RW_HEAD_DIM)
    vh = _heads(v, RW_HEADS, RW_HEAD_DIM)
    kk = _heads(k * k_k, RW_HEADS, RW_HEAD_DIM)
    kk = kk / jnp.maximum(jnp.sqrt(jnp.sum(kk * kk, axis=-1, keepdims=True)), 1e-12)
    ys, bonus, states = [], [], []
    for d in range(2):
        wl = wd[..., d * RW_DECAY_LORA:(d + 1) * RW_DECAY_LORA]
        al = ad[..., d * RW_AAA_LORA:(d + 1) * RW_AAA_LORA]
        w = -jax.nn.softplus(-(w0[d] + jnp.tanh(wl) @ w2[d])) - 0.5
        decay = jnp.exp(-jnp.exp(_heads(w, RW_HEADS, RW_HEAD_DIM)))
        a_flat = jax.nn.sigmoid(a0[d] + al @ a2[d])
        a = _heads(a_flat, RW_HEADS, RW_HEAD_DIM)
        kd = _heads(k * (1.0 + (a_flat - 1.0) * k_a), RW_HEADS, RW_HEAD_DIM)
        y, s = _rwkv7_scan(rh, decay, kd, vh, -kk, kk * a, s0[d], d == 1, emit)
        states.append(s)
        if emit:
            ys.append(y)
            bonus.append(jnp.sum(rh * kd * r_k.astype(jnp.float32), axis=-1, keepdims=True) * vh)
    if not emit:
        return None, (states[0], states[1])
    y = ys[0] + ys[1]
    mu = jnp.mean(y, axis=-1, keepdims=True)
    var = jnp.mean(jnp.square(y - mu), axis=-1, keepdims=True)
    yn = ((y - mu) * lax.rsqrt(var + RW_GN_EPS)).reshape(bsz, l, RW_WIDTH) * lnx_g + lnx_b
    yn = yn + (bonus[0] + bonus[1]).reshape(bsz, l, RW_WIDTH)
    g = jax.nn.sigmoid(gd) @ g2
    return (yn * g).astype(r.dtype), (states[0], states[1])


def _gla_chunked(q, k, v, logf, s0, emit):
    bsz, l, h, _ = q.shape
    dv = v.shape[-1]
    n = l // HG_CHUNK
    blk = lambda t: jnp.moveaxis(t.reshape(bsz, n, HG_CHUNK, h, t.shape[-1]), 3, 1)
    q, k, v, logf = blk(q), blk(k), blk(v), blk(logf)
    cum = jnp.cumsum(logf, axis=3)
    last = cum[:, :, :, -1:, :]
    kv = jnp.einsum('bhnjk,bhnjv->bhnkv', k * jnp.exp(last - cum), v)
    chunk_decay = jnp.exp(last[:, :, :, 0, :])
    def step(s, inp):
        dc, kvc = inp
        return dc[..., None] * s + kvc, s
    s_fin, s_prev = lax.scan(step, s0, (jnp.moveaxis(chunk_decay, 2, 0), jnp.moveaxis(kv, 2, 0)))
    if not emit:
        return None, s_fin
    s_prev = jnp.moveaxis(s_prev, 0, 2)
    ref = cum[:, :, :, HG_CHUNK // 2:HG_CHUNK // 2 + 1, :]
    scores = jnp.einsum('bhnik,bhnjk->bhnij', q * jnp.exp(cum - ref), k * jnp.exp(ref - cum))
    causal = jnp.tril(jnp.ones((HG_CHUNK, HG_CHUNK), dtype=bool))
    scores = jnp.where(causal, scores, 0.0)
    o = (jnp.einsum('bhnij,bhnjv->bhniv', scores, v)
         + jnp.einsum('bhnik,bhnkv->bhniv', q * jnp.exp(cum), s_prev))
    return jnp.moveaxis(o, 1, 3).reshape(bsz, l, h, dv), s_fin


def _hgrn2_mix(cols, s0, lb, norm_g, emit):
    q, f_fw, f_bw, i, g = cols
    bsz, l, _ = q.shape
    qh = _heads(jax.nn.silu(q), HG_HEADS, HG_KEY_DIM) * (HG_KEY_DIM ** -0.5)
    ih = _heads(i, HG_HEADS, HG_VAL_DIM)
    outs, states = [], []
    for d, f_raw in enumerate((f_fw, f_bw)):
        fr = _heads(f_raw, HG_HEADS, HG_KEY_DIM)
        lbd = lb[d].reshape(HG_HEADS, HG_KEY_DIM)
        logf = jnp.log(lbd + (1.0 - lbd) * jax.nn.sigmoid(fr))
        kf = (1.0 - lbd) * jax.nn.sigmoid(-fr)
        args = (qh, kf, ih, logf)
        if d == 1:
            args = tuple(jnp.flip(t, axis=1) for t in args)
        o, s = _gla_chunked(args[0], args[1], args[2], args[3], s0[d], emit)
        states.append(s)
        if emit:
            outs.append(jnp.flip(o, axis=1) if d == 1 else o)
    if not emit:
        return None, (states[0], states[1])
    o = outs[0] + outs[1]
    o = o * lax.rsqrt(jnp.mean(o * o, axis=-1, keepdims=True) + EPS) * norm_g.astype(jnp.float32)
    o = o.reshape(bsz, l, HG_VWIDTH) * jax.nn.silu(g)
    return o.astype(g.dtype), (states[0], states[1])


def _swiglu(x, wg, wu, wd):
    return (jax.nn.silu(x @ wg) * (x @ wu)) @ wd


def _moe(h, router_w, router_b, wg, wu, wd, sg, su, sd):
    t = h.shape[0]
    scores = jax.nn.sigmoid(h.astype(jnp.float32) @ router_w.astype(jnp.float32))
    sel = scores + router_b.astype(jnp.float32)
    grp = sel.reshape(t, N_GROUPS, N_EXPERTS // N_GROUPS)
    grp_score = jnp.sum(lax.top_k(grp, 2)[0], axis=-1)
    _, top_g = lax.top_k(grp_score, TOPK_GROUPS)
    gmask = jnp.any(top_g[:, :, None] == jnp.arange(N_GROUPS)[None, None, :], axis=1)
    sel = jnp.where(jnp.repeat(gmask, N_EXPERTS // N_GROUPS, axis=1), sel, -jnp.inf)
    _, top_e = lax.top_k(sel, TOP_K)
    gate = jnp.take_along_axis(scores, top_e, axis=1)
    gate = gate / jnp.sum(gate, axis=-1, keepdims=True) * ROUTE_SCALE
    n_assign = t * TOP_K
    flat_e = top_e.reshape(-1)
    flat_tok = jnp.arange(n_assign, dtype=jnp.int32) // TOP_K
    flat_gate = gate.reshape(-1)
    order = jnp.argsort(flat_e)
    e_sorted, tok_sorted, gate_sorted = flat_e[order], flat_tok[order], flat_gate[order]
    counts = jnp.bincount(flat_e, length=N_EXPERTS)
    starts = jnp.cumsum(counts) - counts
    padded = (counts + MOE_BLOCK - 1) // MOE_BLOCK * MOE_BLOCK
    pad_end = jnp.cumsum(padded)
    pad_start = pad_end - padded
    dest = pad_start[e_sorted] + (jnp.arange(n_assign, dtype=jnp.int32) - starts[e_sorted])
    n_blocks = -(-n_assign // MOE_BLOCK) + N_EXPERTS
    tok_buf = jnp.zeros((n_blocks * MOE_BLOCK,), jnp.int32).at[dest].set(tok_sorted).reshape(n_blocks, MOE_BLOCK)
    gate_buf = jnp.zeros((n_blocks * MOE_BLOCK,), jnp.float32).at[dest].set(gate_sorted).reshape(n_blocks, MOE_BLOCK)
    blk_e = jnp.minimum(jnp.searchsorted(pad_end, jnp.arange(n_blocks, dtype=jnp.int32) * MOE_BLOCK, side='right'),
                        N_EXPERTS - 1)
    def step(out, inp):
        tok, gw, e = inp
        y = _swiglu(h[tok], wg[e], wu[e], wd[e]) * gw[:, None].astype(h.dtype)
        return out.at[tok].add(y), None
    routed, _ = lax.scan(step, jnp.zeros_like(h), (tok_buf, gate_buf, blk_e))
    return _swiglu(h, sg, su, sd) + routed


def setup_inputs(seed: int = 0) -> dict:
    key = jax.random.key(seed)
    ks = jax.random.split(key, 32)
    nrm = lambda k, shape, scale: jax.random.normal(k, shape, jnp.float32) * scale
    d = D_MODEL
    return {
        'x': nrm(ks[0], (BATCH, SEQ, d), 1.0),
        'c': nrm(ks[1], (BATCH, d), 1.0),
        'ctx': nrm(ks[2], (BATCH, CTX_LEN, d), 1.0),
        'c_ctx': nrm(ks[3], (d,), 1.0),
        'w_mod': nrm(ks[4], (DEPTH, d, N_MOD * d), 0.5 * d ** -0.5),
        'b_mod': nrm(ks[5], (DEPTH, N_MOD * d), 0.02),
        'norm1_g': 1.0 + nrm(ks[6], (DEPTH, d), 0.05),
        'norm2_g': 1.0 + nrm(ks[7], (DEPTH, d), 0.05),
        'w_in': nrm(ks[8], (DEPTH, d, P_IN), d ** -0.5),
        'rw_conv': jnp.zeros((DEPTH, CONV_K, CONV_K, 3 * RW_WIDTH), jnp.float32).at[:, CONV_K // 2, CONV_K // 2, :].set(1.0)
                   + nrm(ks[9], (DEPTH, CONV_K, CONV_K, 3 * RW_WIDTH), 0.15),
        'rw_w0': jax.random.uniform(ks[10], (DEPTH, 2, RW_WIDTH), jnp.float32, -6.0, -1.0),
        'rw_w2': nrm(ks[11], (DEPTH, 2, RW_DECAY_LORA, RW_WIDTH), 0.1),
        'rw_a0': nrm(ks[12], (DEPTH, 2, RW_WIDTH), 0.3),
        'rw_a2': nrm(ks[13], (DEPTH, 2, RW_AAA_LORA, RW_WIDTH), 0.1),
        'rw_g2': nrm(ks[14], (DEPTH, RW_GATE_LORA, RW_WIDTH), RW_GATE_LORA ** -0.5),
        'rw_k_k': 0.85 + nrm(ks[15], (DEPTH, RW_WIDTH), 0.05),
        'rw_k_a': 1.0 + nrm(ks[16], (DEPTH, RW_WIDTH), 0.05),
        'rw_r_k': nrm(ks[17], (DEPTH, RW_HEADS, RW_HEAD_DIM), 0.1),
        'rw_lnx_g': 1.0 + nrm(ks[18], (DEPTH, RW_WIDTH), 0.05),
        'rw_lnx_b': nrm(ks[19], (DEPTH, RW_WIDTH), 0.02),
        'hg_lb_logits': nrm(ks[20], (2, DEPTH + 1, HG_KWIDTH), 0.5),
        'hg_norm_g': 1.0 + nrm(ks[21], (DEPTH, HG_VAL_DIM), 0.05),
        'w_out': nrm(ks[22], (DEPTH, D_MIX, d), D_MIX ** -0.5),
        'router_w': nrm(ks[23], (DEPTH, d, N_EXPERTS), d ** -0.5),
        'router_b': nrm(ks[24], (DEPTH, N_EXPERTS), 0.01),
        'exp_w_gate': nrm(ks[25], (DEPTH, N_EXPERTS, d, D_EXPERT), d ** -0.5),
        'exp_w_up': nrm(ks[26], (DEPTH, N_EXPERTS, d, D_EXPERT), d ** -0.5),
        'exp_w_down': nrm(ks[27], (DEPTH, N_EXPERTS, D_EXPERT, d), D_EXPERT ** -0.5),
        'sh_w_gate': nrm(ks[28], (DEPTH, d, D_SHARED), d ** -0.5),
        'sh_w_up': nrm(ks[29], (DEPTH, d, D_SHARED), d ** -0.5),
        'sh_w_down': nrm(ks[30], (DEPTH, D_SHARED, d), D_SHARED ** -0.5),
        'final_norm_g': 1.0 + nrm(ks[31], (d,), 0.05),
    }


def reference(x, c, ctx, c_ctx, w_mod, b_mod, norm1_g, norm2_g, w_in, rw_conv, rw_w0, rw_w2, rw_a0, rw_a2,
              rw_g2, rw_k_k, rw_k_a, rw_r_k, rw_lnx_g, rw_lnx_b, hg_lb_logits, hg_norm_g, w_out, router_w,
              router_b, exp_w_gate, exp_w_up, exp_w_down, sh_w_gate, sh_w_up, sh_w_down, final_norm_g):
    bsz, seq, d = x.shape
    rows = seq // GRID_W
    ctx_len = ctx.shape[1]
    lb_all = jnp.cumsum(jax.nn.softmax(hg_lb_logits.astype(jnp.float32), axis=1), axis=1)
    zero_rw = jnp.zeros((bsz, RW_HEADS, RW_HEAD_DIM, RW_HEAD_DIM), jnp.float32)
    zero_hg = jnp.zeros((bsz, HG_HEADS, HG_KEY_DIM, HG_VAL_DIM), jnp.float32)
    for l in range(DEPTH):
        last = l == DEPTH - 1
        mod_lat = (jax.nn.silu(c) @ w_mod[l] + b_mod[l])[:, None, :]
        mod_ctx = (jax.nn.silu(c_ctx) @ w_mod[l] + b_mod[l])[None, None, :]
        sh1, sc1, g1, sh2, sc2, g2 = jnp.split(mod_lat, N_MOD, axis=-1)
        csh1, csc1, cg1, csh2, csc2, cg2 = jnp.split(mod_ctx, N_MOD, axis=-1)
        h_lat = _rmsnorm(x, norm1_g[l]) * (1.0 + sc1) + sh1
        h_ctx = _rmsnorm(ctx, norm1_g[l]) * (1.0 + csc1) + csh1
        cols_lat = _split_cols(h_lat @ w_in[l])
        cols_ctx = _split_cols(h_ctx @ w_in[l])
        kern = rw_conv[l]
        rw_p = (rw_w0[l], rw_w2[l], rw_a0[l], rw_a2[l], rw_g2[l], rw_k_k[l], rw_k_a[l], rw_r_k[l],
                rw_lnx_g[l], rw_lnx_b[l])
        lb_l = lb_all[:, l]
        y_rw_ctx, s_rw = _rwkv7_mix(cols_ctx[:6], lambda u: _conv_context(u, kern), (zero_rw, zero_rw), *rw_p,
                                    emit=not last)
        y_rw_lat, _ = _rwkv7_mix(cols_lat[:6], lambda u: _conv_latent(u, kern, rows), s_rw, *rw_p, emit=True)
        y_hg_ctx, s_hg = _hgrn2_mix(cols_ctx[6:], (zero_hg, zero_hg), lb_l, hg_norm_g[l], emit=not last)
        y_hg_lat, _ = _hgrn2_mix(cols_lat[6:], s_hg, lb_l, hg_norm_g[l], emit=True)
        x = x + g1 * (jnp.concatenate([y_rw_lat, y_hg_lat], axis=-1) @ w_out[l])
        moe_p = (router_w[l], router_b[l], exp_w_gate[l], exp_w_up[l], exp_w_down[l],
                 sh_w_gate[l], sh_w_up[l], sh_w_down[l])
        h2_lat = _rmsnorm(x, norm2_g[l]) * (1.0 + sc2) + sh2
        if last:
            x = x + g2 * _moe(h2_lat.reshape(-1, d), *moe_p).reshape(bsz, seq, d)
        else:
            ctx = ctx + cg1 * (jnp.concatenate([y_rw_ctx, y_hg_ctx], axis=-1) @ w_out[l])
            h2_ctx = _rmsnorm(ctx, norm2_g[l]) * (1.0 + csc2) + csh2
            tokens = jnp.concatenate([h2_ctx, h2_lat], axis=1).reshape(-1, d)
            f = _moe(tokens, *moe_p).reshape(bsz, ctx_len + seq, d)
            ctx = ctx + cg2 * f[:, :ctx_len]
            x = x + g2 * f[:, ctx_len:]
    return _rmsnorm(x, final_norm_g)
```

```cpp
#include <hip/hip_runtime.h>
#include <cstdio>
#include <cstdint>

#ifndef MK_N_LAUNCHES
#define MK_N_LAUNCHES 1
#endif

#define GAS __attribute__((address_space(1)))
#define LAS __attribute__((address_space(3)))
typedef unsigned short bf16_t;
typedef short bf16x8 __attribute__((ext_vector_type(8)));
typedef float f32x4 __attribute__((ext_vector_type(4)));
typedef float f32x2 __attribute__((ext_vector_type(2)));
typedef float f32x16 __attribute__((ext_vector_type(16)));
typedef unsigned u32x4 __attribute__((ext_vector_type(4)));
typedef unsigned u32x2 __attribute__((ext_vector_type(2)));
typedef GAS unsigned gu32;
typedef const GAS float* gcf;

constexpr int NB = 16, SEQ = 2048, DM = 1024, CTXL = 256, NT = NB * SEQ, NTC = NB * CTXL, MROWS = NT + NTC;
constexpr int LD_RW = 2048, LD_HG = 2560, N_IN = 4608, P_IN = 4480;
constexpr int NEXP = 64, NCH = 4, TCH = NT / NCH, CAPE = TCH;
constexpr int NMOD = 6 * DM;
constexpr int TCS = 32;
constexpr int ROWS_CH = 90368;

constexpr size_t MiB = 1u << 20;
constexpr size_t WS_CTL = 0, CTL_ZERO_BYTES = 1 * MiB;
constexpr size_t WS_MODF = 1 * MiB;
constexpr size_t WS_MODP = 2 * MiB;
constexpr size_t WS_RWT = 9 * MiB;
constexpr size_t WS_G2T = 9 * MiB + 512 * 1024;
constexpr size_t WS_WIN = 10 * MiB;
constexpr size_t WS_WOUT = 19 * MiB;
constexpr size_t WS_W1E = 21 * MiB;
constexpr size_t WS_W2E = 86 * MiB;
constexpr size_t WS_SLOT = 119 * MiB;
constexpr size_t WS_GATE = 120 * MiB;
constexpr size_t WS_TOKL = 121 * MiB;
constexpr size_t WS_BIG = 130 * MiB;
constexpr size_t WS_CRW = WS_BIG;
constexpr size_t WS_CHG = WS_BIG + 144 * MiB;
constexpr size_t WS_VCONV = WS_BIG + 324 * MiB;
constexpr size_t WS_CSC = WS_BIG + 356 * MiB;
constexpr size_t WS_H2 = WS_BIG;
constexpr size_t WS_ACT = WS_BIG + 64 * MiB;
constexpr size_t WS_Y = WS_BIG + 110 * MiB;
constexpr size_t WS_END = 512 * MiB;
static_assert(WS_CSC + 2 * MiB <= WS_END && WS_Y + (size_t)ROWS_CH * 2048 <= WS_END && WS_ACT + (size_t)ROWS_CH * 512 <= WS_Y, "ws map");
constexpr int CW_TMO = 0, CW_CODE = 1, CW_BAR = 4096, CW_GCNT = 16384;

constexpr int RING_BYTES = 131072;
constexpr int LDSCTL_OFF = RING_BYTES, MISC_OFF = LDSCTL_OFF + 320, TBL_OFF = LDSCTL_OFF + 1024;
constexpr int LDS_BYTES = 147456;

#define RLX_AGENT __ATOMIC_RELAXED, __HIP_MEMORY_SCOPE_AGENT
#define LDS_WAIT() asm volatile("s_waitcnt lgkmcnt(0)" ::: "memory")
#define VM_WAIT() asm volatile("s_waitcnt vmcnt(0)" ::: "memory")
__device__ __forceinline__ unsigned f2bf(float f) { unsigned u = __builtin_bit_cast(unsigned, f); return (u + 0x7fffu + ((u >> 16) & 1u)) >> 16; }
__device__ __forceinline__ unsigned pk2(float lo, float hi) { return f2bf(lo) | (f2bf(hi) << 16); }
__device__ __forceinline__ float bf2f(unsigned short h) { return __builtin_bit_cast(float, (unsigned)h << 16); }
__device__ __forceinline__ float bflo(unsigned w) { return __builtin_bit_cast(float, w << 16); }
__device__ __forceinline__ float bfhi(unsigned w) { return __builtin_bit_cast(float, w & 0xffff0000u); }
__device__ __forceinline__ float sigmoidf_(float x) { return 1.0f / (1.0f + __expf(-x)); }
__device__ __forceinline__ float siluf_(float x) { return x / (1.0f + __expf(-x)); }
template <int CTRL> __device__ __forceinline__ float dppf(float x) { return __builtin_bit_cast(float, __builtin_amdgcn_update_dpp(0, __builtin_bit_cast(int, x), CTRL, 0xf, 0xf, true)); }
__device__ __forceinline__ float row16_sum(float x) {
    x += dppf<0xB1>(x);
    x += dppf<0x4E>(x);
    x += dppf<0x141>(x);
    x += dppf<0x140>(x);
    return x;
}
__device__ __forceinline__ float row16_max(float x) {
    x = fmaxf(x, dppf<0xB1>(x)); x = fmaxf(x, dppf<0x4E>(x)); x = fmaxf(x, dppf<0x141>(x)); x = fmaxf(x, dppf<0x140>(x));
    return x;
}
__device__ __forceinline__ float rdl(float x, int l) { return __builtin_bit_cast(float, __builtin_amdgcn_readlane(__builtin_bit_cast(int, x), l)); }
__device__ __forceinline__ float wave_sum(float v) { v = row16_sum(v); return (rdl(v, 0) + rdl(v, 16)) + (rdl(v, 32) + rdl(v, 48)); }
__device__ __forceinline__ float wave_max(float v) { v = row16_max(v); return fmaxf(fmaxf(rdl(v, 0), rdl(v, 16)), fmaxf(rdl(v, 32), rdl(v, 48))); }
__device__ __forceinline__ float oct_sum(float x) { x += dppf<0xB1>(x); x += dppf<0x4E>(x); x += dppf<0x141>(x); return x; }
__device__ __forceinline__ float oct_max(float x) { x = fmaxf(x, dppf<0xB1>(x)); x = fmaxf(x, dppf<0x4E>(x)); x = fmaxf(x, dppf<0x141>(x)); return x; }
__device__ __forceinline__ int oct_min(int x) {
    x = min(x, __builtin_amdgcn_update_dpp(0, x, 0xB1, 0xf, 0xf, true)); x = min(x, __builtin_amdgcn_update_dpp(0, x, 0x4E, 0xf, 0xf, true)); x = min(x, __builtin_amdgcn_update_dpp(0, x, 0x141, 0xf, 0xf, true));
    return x;
}

namespace pg8 {
constexpr int BM = 256, BK = 64, HALF = 128, HTB = HALF * BK * 2, STAGE_BYTES = 8 * HTB, NXCD = 8, WGM = 8;
__host__ __device__ __forceinline__ int lds_byte(int r, int c) { const int st = (r >> 4) * 2 + (c >> 5), rr = r & 15, cc = c & 31, ob = rr * 64 + cc * 2; return st * 1024 + (ob ^ (((ob >> 9) & 1) << 5)); }
__host__ __device__ __forceinline__ void stage_rc(int b, int& R, int& C) { const int st = b / 1024, sb = b % 1024, swz = sb ^ (((sb >> 9) & 1) << 5); R = (st >> 1) * 16 + swz / 64; C = (st & 1) * 32 + (swz % 64) / 2; }
__host__ __device__ __forceinline__ int perm32(int rho) { const int n = rho >> 4, i = rho & 15; return 8 * (i >> 2) + 4 * n + (i & 3); }

struct Unit { int arow, brow, gofs, nvalid, orow, pn; };
struct Gemm { const bf16_t* A; const bf16_t* Bt; const int* gidx; int lda; int K; };

struct StaticOrder {
    int nM, nN, nwg, G, c;
    __device__ void init(int M, int N, int G_, int c_) { nM = M / BM; nN = N / BM; nwg = nM * nN; G = G_; c = c_; }
    __device__ bool next(int i, Unit& u) const {
        const long L = (long)i * G + c; if (L >= nwg) return false;
        int wgid = (int)L; { const int q = nwg / NXCD, r = nwg % NXCD, xcd = wgid % NXCD, off = wgid / NXCD; wgid = (xcd < r ? xcd * (q + 1) : r * (q + 1) + (xcd - r) * q) + off; }
        const int nig = WGM * nN, gid = wgid / nig, fm = gid * WGM, gsz = (nM - fm) < WGM ? (nM - fm) : WGM;
        const int pm = fm + ((wgid % nig) % gsz), pn = (wgid % nig) / gsz;
        u.arow = pm * BM; u.brow = pn * BM; u.gofs = 0; u.nvalid = BM; u.orow = pm * BM; u.pn = pn; return true;
    }
};
struct ListOrder {
    const LAS int* ul; int n;
    __device__ bool next(int i, Unit& u) const {
        if (i >= n) return false;
        const LAS int* p = ul + i * 8;
        u.arow = p[0]; u.brow = p[1]; u.gofs = p[2]; u.nvalid = p[3]; u.orow = p[4]; u.pn = p[5]; return true;
    }
};

__device__ __forceinline__ unsigned cvt_pk_bf16(float lo, float hi) { unsigned r; asm volatile("v_cvt_pk_bf16_f32 %0, %1, %2" : "=v"(r) : "v"(lo), "v"(hi)); return r; }

template <class Epi, class Sched, bool GATHER, bool ALIGN_EPI>
__device__ __forceinline__ void gemm_phase(LAS unsigned char* lds, const Gemm g, const Sched& S, const Epi& E, const int tid) {
    const int wid = __builtin_amdgcn_readfirstlane(tid >> 6), lane = tid & 63, wr = wid >> 2, wc = wid & 3, fr = lane & 15, fq = lane >> 4;
    const int K = g.K, nt = K / BK, lda = g.lda;
    int sR[2], sC[2]; unsigned voffB[2];
#pragma unroll
    for (int i = 0; i < 2; ++i) { int R, C; stage_rc(tid * 16 + i * 8192, R, C); const int Rb = Epi::PERM ? ((R & ~31) + perm32(R & 31)) : R; sR[i] = R; sC[i] = C; voffB[i] = (unsigned)(Rb * K + C) * 2u; }
    const size_t kstep = (size_t)(BK * 2);
    const size_t hstepB = (size_t)HALF * K * 2;
    const unsigned ldsw = (unsigned)wid * 1024u;
    const int aoff = lds_byte(wr * 64 + fr, fq * 8), boff = lds_byte(wc * 32 + fr, fq * 8);
#define PG8_SA(b, h) (((b) * 2 + (h)) * HTB)
#define PG8_SB(b, h) ((4 + (b) * 2 + (h)) * HTB)
#define PG8_STAGE(bufoff, gbase, v0, v1) do { \
        __builtin_amdgcn_global_load_lds((const unsigned*)((const char*)(gbase) + (v0)), (LAS unsigned*)(lds + (bufoff) + ldsw), 16, 0, 0); \
        __builtin_amdgcn_global_load_lds((const unsigned*)((const char*)(gbase) + (v1)), (LAS unsigned*)(lds + (bufoff) + ldsw + 8192), 16, 0, 0); } while (0)
#define PG8_LDA(dst, b, h) do { _Pragma("unroll") for (int m = 0; m < 4; ++m) _Pragma("unroll") for (int k = 0; k < 2; ++k) dst[m][k] = *(const LAS bf16x8*)(lds + PG8_SA(b, h) + aoff + m * 2048 + k * 1024); } while (0)
#define PG8_LDB(dst, b, h) do { _Pragma("unroll") for (int n = 0; n < 2; ++n) _Pragma("unroll") for (int k = 0; k < 2; ++k) dst[n][k] = *(const LAS bf16x8*)(lds + PG8_SB(b, h) + boff + n * 2048 + k * 1024); } while (0)
#define PG8_MMA(ai, bj, At, Bt) do { __builtin_amdgcn_s_setprio(1); _Pragma("unroll") for (int m = 0; m < 4; ++m) _Pragma("unroll") for (int n = 0; n < 2; ++n) _Pragma("unroll") for (int k = 0; k < 2; ++k) \
        acc[ai][bj][m][n] = __builtin_amdgcn_mfma_f32_16x16x32_bf16(Bt[n][k], At[m][k], acc[ai][bj][m][n], 0, 0, 0); __builtin_amdgcn_s_setprio(0); } while (0)
#define PG8_WAIT_V(n) asm volatile("s_waitcnt vmcnt(" #n ")" ::: "memory")
#define PG8_WAIT_L(n) asm volatile("s_waitcnt lgkmcnt(" #n ")" ::: "memory")
#define PG8_BAR __builtin_amdgcn_s_barrier()
#define PG8_SCHED __builtin_amdgcn_sched_barrier(0)
#define PG8_AOFFS(u, v00, v01, v10, v11) do { int r_[4] = {sR[0], sR[1], 128 + sR[0], 128 + sR[1]}; unsigned o_[4]; _Pragma("unroll") for (int q_ = 0; q_ < 4; ++q_) { int row_; \
        if (GATHER) row_ = (r_[q_] < (u).nvalid) ? ((u).gofs >= 0 ? g.gidx[(u).gofs + r_[q_]] : (u).arow + r_[q_]) : 0; else row_ = (u).arow + r_[q_]; \
        o_[q_] = (unsigned)(row_ * lda + sC[q_ & 1]) * 2u; } v00 = o_[0]; v01 = o_[1]; v10 = o_[2]; v11 = o_[3]; } while (0)
#define PG8_STAGE_A(bufoff, ptr, h) do { if constexpr (GATHER) { if (h) PG8_STAGE(bufoff, ptr, c10, c11); else PG8_STAGE(bufoff, ptr, c00, c01); } \
        else { PG8_STAGE(bufoff, (ptr) + (h) * hstepA, voffA0, voffA1); } } while (0)
    Unit cur, nxt; int ui = 0;
    if (!S.next(0, cur)) return;
    f32x4 acc[2][2][4][2];
    float zf = 0.f; asm volatile("" : "+v"(zf));
#pragma unroll
    for (int a = 0; a < 2; ++a)
#pragma unroll
        for (int b = 0; b < 2; ++b)
#pragma unroll
            for (int m = 0; m < 4; ++m)
#pragma unroll
                for (int n = 0; n < 2; ++n) acc[a][b][m][n] = (f32x4){zf, zf, zf, zf};
    bf16x8 At[4][2], B0[2][2], B1[2][2];
    const size_t hstepA = (size_t)HALF * lda * 2;
    const unsigned voffA0 = (unsigned)(sR[0] * lda + sC[0]) * 2u, voffA1 = (unsigned)(sR[1] * lda + sC[1]) * 2u;
    unsigned c00 = 0, c01 = 0, c10 = 0, c11 = 0, n00 = 0, n01 = 0, n10 = 0, n11 = 0;
    if constexpr (GATHER) { PG8_AOFFS(cur, c00, c01, c10, c11); }
    const char* gA = (const char*)g.A;
    const char* cA = GATHER ? gA : gA + (size_t)cur.arow * lda * 2;
    const char* cB = (const char*)g.Bt + (size_t)cur.brow * K * 2;
    PG8_STAGE(PG8_SB(0, 0), cB, voffB[0], voffB[1]); PG8_STAGE(PG8_SB(0, 1), cB + hstepB, voffB[0], voffB[1]); PG8_STAGE_A(PG8_SA(0, 0), cA, 0); PG8_STAGE_A(PG8_SA(0, 1), cA, 1);
    if (wr == 1) PG8_BAR;
    PG8_WAIT_V(2); PG8_BAR;
    PG8_STAGE(PG8_SB(1, 0), cB + kstep, voffB[0], voffB[1]); PG8_STAGE_A(PG8_SA(1, 0), cA + kstep, 0); PG8_STAGE(PG8_SB(1, 1), cB + hstepB + kstep, voffB[0], voffB[1]);
    PG8_WAIT_V(6); PG8_BAR;
    for (;;) {
        const bool has_next = S.next(ui + 1, nxt);
        if constexpr (GATHER) { if (has_next) { PG8_AOFFS(nxt, n00, n01, n10, n11); } else { n00 = c00; n01 = c01; n10 = c10; n11 = c11; } }
        const char* nA = (GATHER || !has_next) ? cA : gA + (size_t)nxt.arow * lda * 2;
        const char* nB = has_next ? (const char*)g.Bt + (size_t)nxt.brow * K * 2 : cB;
#pragma unroll 1
        for (int t = 0; t < nt; t += 2) {
            const bool last = (t == nt - 2);
            const char* a1 = cA + (size_t)(t + 1) * kstep;
            const char* b2 = last ? nB : cB + (size_t)(t + 2) * kstep;
            const char* b3 = b2 + kstep;
            PG8_LDB(B0, 0, 0); PG8_LDB(B1, 0, 1); PG8_SCHED; PG8_LDA(At, 0, 0); PG8_STAGE_A(PG8_SA(1, 1), a1, 1);
            PG8_WAIT_V(8); PG8_WAIT_L(0); PG8_BAR; PG8_MMA(0, 0, At, B0); PG8_MMA(0, 1, At, B1); PG8_BAR; PG8_SCHED;
            if constexpr (GATHER) { if (last) { c00 = n00; c01 = n01; c10 = n10; c11 = n11; } }
            const char* a2 = last ? nA : cA + (size_t)(t + 2) * kstep;
            const char* a3 = a2 + kstep;
            PG8_LDA(At, 0, 1); PG8_STAGE(PG8_SB(0, 0), b2, voffB[0], voffB[1]); PG8_STAGE(PG8_SB(0, 1), b2 + hstepB, voffB[0], voffB[1]); PG8_STAGE_A(PG8_SA(0, 0), a2, 0);
            PG8_WAIT_V(8); PG8_WAIT_L(0); PG8_BAR; PG8_MMA(1, 0, At, B0); PG8_MMA(1, 1, At, B1); PG8_BAR; PG8_SCHED;
            PG8_LDB(B0, 1, 0); PG8_LDB(B1, 1, 1); PG8_SCHED; PG8_LDA(At, 1, 0); PG8_STAGE_A(PG8_SA(0, 1), a2, 1);
            PG8_WAIT_V(8); PG8_WAIT_L(0); PG8_BAR; PG8_MMA(0, 0, At, B0); PG8_MMA(0, 1, At, B1); PG8_BAR; PG8_SCHED;
            PG8_LDA(At, 1, 1); PG8_STAGE(PG8_SB(1, 0), b3, voffB[0], voffB[1]); PG8_STAGE(PG8_SB(1, 1), b3 + hstepB, voffB[0], voffB[1]); PG8_STAGE_A(PG8_SA(1, 0), a3, 0);
            PG8_WAIT_V(8); PG8_WAIT_L(0); PG8_BAR; PG8_MMA(1, 0, At, B0); PG8_MMA(1, 1, At, B1); PG8_BAR; PG8_SCHED;
        }
        if constexpr (ALIGN_EPI) { if (wr == 0) PG8_BAR; }
        E(acc, cur, wr, wc, fr, fq);
        if (!has_next) break;
#pragma unroll
        for (int a = 0; a < 2; ++a)
#pragma unroll
            for (int b = 0; b < 2; ++b)
#pragma unroll
                for (int m = 0; m < 4; ++m)
#pragma unroll
                    for (int n = 0; n < 2; ++n) acc[a][b][m][n] = (f32x4){zf, zf, zf, zf};
        cur = nxt; cA = nA; cB = nB; ++ui;
        if constexpr (ALIGN_EPI) { if (wr == 1) PG8_BAR; }
    }
    PG8_WAIT_V(0);
    if constexpr (!ALIGN_EPI) { if (wr == 0) PG8_BAR; }
    PG8_BAR;
#undef PG8_STAGE_A
#undef PG8_SA
#undef PG8_SB
#undef PG8_STAGE
#undef PG8_LDA
#undef PG8_LDB
#undef PG8_MMA
#undef PG8_WAIT_V
#undef PG8_WAIT_L
#undef PG8_BAR
#undef PG8_SCHED
#undef PG8_AOFFS
}

struct EpiCols {
    static constexpr bool PERM = true;
    bf16_t* crw; bf16_t* chg;
    __device__ __forceinline__ void operator()(const f32x4 (&acc)[2][2][4][2], const Unit& u, int wr, int wc, int fr, int fq) const {
        bf16_t* base; int ldc, colt;
        if (u.pn < 8) { base = crw; ldc = LD_RW; colt = u.pn * 256; } else { base = chg; ldc = LD_HG; colt = (u.pn - 8) * 256; }
        const int row0 = u.orow + wr * 64 + fr, col0 = colt + wc * 32 + 8 * fq;
#pragma unroll
        for (int ai = 0; ai < 2; ++ai)
#pragma unroll
            for (int m = 0; m < 4; ++m) { bf16_t* rowp = base + (size_t)(row0 + ai * HALF + m * 16) * ldc + col0;
#pragma unroll
                for (int bj = 0; bj < 2; ++bj) { const f32x4 v0 = acc[ai][bj][m][0], v1 = acc[ai][bj][m][1];
                    u32x4 w; w.x = cvt_pk_bf16(v0[0], v0[1]); w.y = cvt_pk_bf16(v0[2], v0[3]); w.z = cvt_pk_bf16(v1[0], v1[1]); w.w = cvt_pk_bf16(v1[2], v1[3]);
                    *(u32x4*)(rowp + bj * HALF) = w; } }
    }
};
struct EpiBf {
    static constexpr bool PERM = true;
    bf16_t* O; int ldc;
    __device__ __forceinline__ void operator()(const f32x4 (&acc)[2][2][4][2], const Unit& u, int wr, int wc, int fr, int fq) const {
        const int row0 = u.orow + wr * 64 + fr, col0 = u.pn * 256 + wc * 32 + 8 * fq;
#pragma unroll
        for (int ai = 0; ai < 2; ++ai)
#pragma unroll
            for (int m = 0; m < 4; ++m) { bf16_t* rowp = O + (size_t)(row0 + ai * HALF + m * 16) * ldc + col0;
#pragma unroll
                for (int bj = 0; bj < 2; ++bj) { const f32x4 v0 = acc[ai][bj][m][0], v1 = acc[ai][bj][m][1];
                    u32x4 w; w.x = cvt_pk_bf16(v0[0], v0[1]); w.y = cvt_pk_bf16(v0[2], v0[3]); w.z = cvt_pk_bf16(v1[0], v1[1]); w.w = cvt_pk_bf16(v1[2], v1[3]);
                    *(u32x4*)(rowp + bj * HALF) = w; } }
    }
};
struct EpiSwiglu {
    static constexpr bool PERM = true;
    bf16_t* O;
    __device__ __forceinline__ void operator()(const f32x4 (&acc)[2][2][4][2], const Unit& u, int wr, int wc, int fr, int fq) const {
        const int row0 = u.orow + wr * 64 + fr, col0 = u.pn * 128 + wc * 16 + 4 * fq;
#pragma unroll
        for (int ai = 0; ai < 2; ++ai)
#pragma unroll
            for (int m = 0; m < 4; ++m) { bf16_t* rowp = O + (size_t)(row0 + ai * HALF + m * 16) * 256 + col0;
#pragma unroll
                for (int bj = 0; bj < 2; ++bj) { const f32x4 v0 = acc[ai][bj][m][0], v1 = acc[ai][bj][m][1];
                    const float a0 = siluf_(v0[0]) * v0[1], a1 = siluf_(v0[2]) * v0[3], a2 = siluf_(v1[0]) * v1[1], a3 = siluf_(v1[2]) * v1[3];
                    u32x2 w; w.x = cvt_pk_bf16(a0, a1); w.y = cvt_pk_bf16(a2, a3);
                    *(u32x2*)(rowp + bj * 64) = w; } }
    }
};
struct EpiX1 {
    static constexpr bool PERM = false;
    gcf x; const float* modf; float* out;
    __device__ __forceinline__ void operator()(const f32x4 (&acc)[2][2][4][2], const Unit& u, int wr, int wc, int fr, int fq) const {
        const int row0 = u.orow + wr * 64 + fr, col0 = u.pn * 256 + wc * 32 + 4 * fq;
        const float* g1 = modf + (size_t)(u.orow >> 11) * NMOD + 2 * DM + col0;
        f32x4 gv[2][2];
#pragma unroll
        for (int bj = 0; bj < 2; ++bj)
#pragma unroll
            for (int n = 0; n < 2; ++n) gv[bj][n] = *(const f32x4*)(g1 + bj * HALF + n * 16);
#pragma unroll
        for (int ai = 0; ai < 2; ++ai)
#pragma unroll
            for (int m = 0; m < 4; ++m) { const size_t off = (size_t)(row0 + ai * HALF + m * 16) * DM + col0;
#pragma unroll
                for (int bj = 0; bj < 2; ++bj)
#pragma unroll
                    for (int n = 0; n < 2; ++n) { const f32x4 xv = *(const GAS f32x4*)(x + off + bj * HALF + n * 16);
                        *(f32x4*)(out + off + bj * HALF + n * 16) = xv + gv[bj][n] * acc[ai][bj][m][n]; } }
    }
};
}

#define XB_TMO      128
#define XB_XCNT(j)  (256  + 64 * (j))
#define XB_XSUB(j)  (1280 + 64 * (j))
#define XB_XGEN(j)  (2304 + 64 * (j))
#define XB_TOP      3328
#define XB_TOPGEN   3392
#define XCD_BAR_WORDS 3456
#define XB_SPIN_CAP (1u << 22)
__device__ __forceinline__ unsigned xb_ld(unsigned* p)              { return __hip_atomic_load(p, __ATOMIC_RELAXED, __HIP_MEMORY_SCOPE_AGENT); }
__device__ __forceinline__ unsigned xb_add(unsigned* p, unsigned v) { return __hip_atomic_fetch_add(p, v, __ATOMIC_RELAXED, __HIP_MEMORY_SCOPE_AGENT); }
__device__ __forceinline__ unsigned xb_xcc_id() { return (unsigned)__builtin_amdgcn_s_getreg((3 << 11) | 20) & 0xFu; }
#define XB_SPIN(cond, bar) do { unsigned _sp = 0; while (cond) { __builtin_amdgcn_s_sleep(1); \
    if ((++_sp & 255u) == 0u) { if (xb_ld(&(bar)[XB_TMO])) break; if (_sp > XB_SPIN_CAP) { atomicAdd(&(bar)[XB_TMO], 1u); break; } } } } while (0)
struct XcdBarrier { unsigned* bar; unsigned x; volatile LAS unsigned* st; };
__device__ __forceinline__ XcdBarrier xcd_barrier_post(unsigned* bar, volatile LAS unsigned* st) {
    XcdBarrier b; b.bar = bar; b.x = xb_xcc_id(); b.st = st;
    if (threadIdx.x == 0) (void)xb_add(&bar[XB_XCNT(b.x)], 1u);
    return b;
}
__device__ __forceinline__ void xcd_barrier_complete(unsigned* bar, unsigned x, unsigned& nloc, unsigned& nx) {
    const unsigned G = gridDim.x * gridDim.y * gridDim.z;
    unsigned sum, cnt, mine, sp = 0u;
    for (;;) {
        sum = 0u; cnt = 0u; mine = 0u;
#pragma unroll 1
        for (unsigned j = 0; j < 16; ++j) { const unsigned c = xb_ld(&bar[XB_XCNT(j)]); sum += c; cnt += (c > 0u) ? 1u : 0u; mine = (j == x) ? c : mine; }
        if (sum == G) break;
        __builtin_amdgcn_s_sleep(1);
        if ((++sp & 255u) == 0u) { if (xb_ld(&bar[XB_TMO])) break; if (sp > XB_SPIN_CAP) { atomicAdd(&bar[XB_TMO], 1u); break; } }
    }
    nloc = mine > 0u ? mine : 1u; nx = cnt > 0u ? cnt : 1u;
}
__device__ __forceinline__ void xcd_barrier(const XcdBarrier& b) {
    asm volatile("s_waitcnt vmcnt(0)" ::: "memory");
    __syncthreads();
    if (threadIdx.x == 0) {
        unsigned* bar = b.bar;
        __builtin_amdgcn_s_waitcnt(0);
        unsigned nloc = b.st[0], nx = b.st[1];
        if (nloc == 0u) { xcd_barrier_complete(bar, b.x, nloc, nx); b.st[0] = nloc; b.st[1] = nx; }
        const unsigned old = xb_add(&bar[XB_XSUB(b.x)], 1u);
        const unsigned gen = old / nloc;
        if (old + 1u == (gen + 1u) * nloc) {
            __builtin_amdgcn_fence(__ATOMIC_RELEASE, "agent");
            asm volatile("s_waitcnt vmcnt(0)" ::: "memory");
            const unsigned og = xb_add(&bar[XB_TOP], 1u);
            const unsigned tg = og / nx;
            if (og + 1u == (tg + 1u) * nx) xb_add(&bar[XB_TOPGEN], 1u);
            else XB_SPIN(xb_ld(&bar[XB_TOPGEN]) == tg, bar);
            __builtin_amdgcn_fence(__ATOMIC_ACQUIRE, "agent");
            xb_add(&bar[XB_XGEN(b.x)], 1u);
            asm volatile("s_waitcnt vmcnt(0)" ::: "memory");
        } else {
            XB_SPIN(xb_ld(&bar[XB_XGEN(b.x)]) == gen, bar);
            __builtin_amdgcn_fence(__ATOMIC_ACQUIRE, "agent");
            asm volatile("s_waitcnt vmcnt(0)" ::: "memory");
        }
    }
    __syncthreads();
}

struct Frame {
    LAS unsigned char* lds;
    volatile LAS unsigned* MISC;
    gu32* ctl;
    int tid, lane, wave, bid, G;
    const gcf __attribute__((address_space(4)))* inp;
    float* out; unsigned char* ws;
};
#define LAUNDER(F) do { asm volatile("" : "+s"((F).ws), "+s"((F).out), "+s"((F).inp)); } while (0)
enum { I_X = 0, I_C, I_CTX, I_CCTX, I_WMOD, I_BMOD, I_N1G, I_N2G, I_WIN, I_CONV, I_W0, I_W2, I_A0, I_A2, I_G2, I_KK, I_KA, I_RK, I_LNG, I_LNB, I_LB, I_HGN, I_WOUT, I_RW, I_RB, I_EG, I_EU, I_ED, I_SG, I_SU, I_SD, I_FNG };

__device__ __forceinline__ void p0_transpose_item(gcf W, int K, int N, bf16_t* WT, int row_mul, int row_add, LAS float* scr, int item, int lane) {
    const int nblk = N / 32, kb = item / nblk, nb = item % nblk, k0 = 64 * kb, n0 = 32 * nb;
#pragma unroll 8
    for (int i = 0; i < 32; ++i) { const int kk = 2 * i + (lane >> 5); scr[kk * 33 + (lane & 31)] = W[(size_t)(k0 + kk) * N + n0 + (lane & 31)]; }
    LDS_WAIT(); asm volatile("" ::: "memory");
    const int c = lane & 7;
#pragma unroll
    for (int j = 0; j < 4; ++j) { const int n = (lane >> 3) + 8 * j; const LAS float* s = scr + (8 * c) * 33 + n;
        u32x4 o; o.x = pk2(s[0 * 33], s[1 * 33]); o.y = pk2(s[2 * 33], s[3 * 33]); o.z = pk2(s[4 * 33], s[5 * 33]); o.w = pk2(s[6 * 33], s[7 * 33]);
        *(GAS u32x4*)(WT + (size_t)((n0 + n) * row_mul + row_add) * K + k0 + 8 * c) = o; }
    LDS_WAIT(); asm volatile("" ::: "memory");
}
__device__ __forceinline__ void p0a(Frame& F) {
    LAUNDER(F);
    LAS float* scr = (LAS float*)(F.lds + F.wave * 16384);
    const int gw = F.bid * 8 + F.wave, NGW = F.G * 8;
    unsigned char* ws = F.ws;
    bf16_t* WIN = (bf16_t*)(ws + WS_WIN); bf16_t* WOUT = (bf16_t*)(ws + WS_WOUT); bf16_t* W1E = (bf16_t*)(ws + WS_W1E); bf16_t* W2E = (bf16_t*)(ws + WS_W2E); bf16_t* G2T = (bf16_t*)(ws + WS_G2T);
    constexpr int I_IN = 16 * 140, I_OUT = 16 * 32, I_E1 = 128, I_E2 = 128, I_G2T = 2 * 16;
    constexpr int NITEMS = I_IN + I_OUT + 64 * (2 * I_E1 + I_E2) + (2 * I_E1 + I_E2) + I_G2T;
    for (int it = gw; it < NITEMS; it += NGW) {
        int r = it;
        if (r < I_IN) { const int nb = r % 140; p0_transpose_item(F.inp[I_WIN], DM, P_IN, WIN, 1, (nb * 32 >= 1920) ? 128 : 0, scr, r, F.lane); continue; } r -= I_IN;
        if (r < I_OUT) { p0_transpose_item(F.inp[I_WOUT], DM, DM, WOUT, 1, 0, scr, r, F.lane); continue; } r -= I_OUT;
        if (r < 64 * (2 * I_E1 + I_E2)) {
            const int e = r / (2 * I_E1 + I_E2), q = r % (2 * I_E1 + I_E2);
            if (q < I_E1) p0_transpose_item(F.inp[I_EG] + (size_t)e * DM * 256, DM, 256, W1E + (size_t)e * 512 * DM, 2, 0, scr, q, F.lane);
            else if (q < 2 * I_E1) p0_transpose_item(F.inp[I_EU] + (size_t)e * DM * 256, DM, 256, W1E + (size_t)e * 512 * DM, 2, 1, scr, q - I_E1, F.lane);
            else p0_transpose_item(F.inp[I_ED] + (size_t)e * 256 * DM, 256, DM, W2E + (size_t)e * DM * 256, 1, 0, scr, q - 2 * I_E1, F.lane);
            continue; } r -= 64 * (2 * I_E1 + I_E2);
        if (r < 2 * I_E1 + I_E2) {
            if (r < I_E1) p0_transpose_item(F.inp[I_SG], DM, 256, W1E + (size_t)64 * 512 * DM, 2, 0, scr, r, F.lane);
            else if (r < 2 * I_E1) p0_transpose_item(F.inp[I_SU], DM, 256, W1E + (size_t)64 * 512 * DM, 2, 1, scr, r - I_E1, F.lane);
            else p0_transpose_item(F.inp[I_SD], 256, DM, W2E + (size_t)64 * DM * 256, 1, 0, scr, r - 2 * I_E1, F.lane);
            continue; } r -= 2 * I_E1 + I_E2;
        p0_transpose_item(F.inp[I_G2], 128, 512, G2T, 1, 0, scr, r, F.lane);
    }
    { const int gt = F.bid * 512 + F.tid; unsigned zu = 0u; asm volatile("" : "+v"(zu)); if (gt < 128 * 1024 / 8) *(GAS u32x4*)(WIN + (size_t)1920 * DM + (size_t)gt * 8) = (u32x4){zu, zu, zu, zu}; }
    { float* RWT = (float*)(ws + WS_RWT); const int gt = F.bid * 512 + F.tid; if (gt < 65536) { const int e = gt >> 10, col = gt & 1023; RWT[gt] = F.inp[I_RW][col * 64 + e]; } }
    float* MODP = (float*)(ws + WS_MODP);
    for (int q = gw; q < 96 * 16; q += NGW) {
        const int cg = q % 96, ks = q / 96, col = cg * 64 + F.lane, k0 = ks * 64;
        float sv[17], acc[17];
#pragma unroll
        for (int b = 0; b < 17; ++b) { const float cv = (b < 16) ? F.inp[I_C][b * DM + k0 + F.lane] : F.inp[I_CCTX][k0 + F.lane]; sv[b] = siluf_(cv); acc[b] = 0.f; }
        gcf wp = F.inp[I_WMOD] + (size_t)k0 * NMOD + col;
#pragma unroll 8
        for (int kk = 0; kk < 64; ++kk) { const float w = wp[(size_t)kk * NMOD];
#pragma unroll
            for (int b = 0; b < 17; ++b) acc[b] += __builtin_bit_cast(float, __builtin_amdgcn_readlane(__builtin_bit_cast(int, sv[b]), kk)) * w; }
#pragma unroll
        for (int b = 0; b < 17; ++b) MODP[(size_t)(ks * 17 + b) * NMOD + col] = acc[b];
    }
}
__device__ __forceinline__ float mod_val(Frame& F, int b, int j) {
    const float* MODP = (const float*)(F.ws + WS_MODP);
    float s = F.inp[I_BMOD][j];
#pragma unroll
    for (int ks = 0; ks < 16; ++ks) s += MODP[(size_t)(ks * 17 + b) * NMOD + j];
    return s;
}
__device__ __forceinline__ void h_rows(Frame& F, gcf src, bf16_t* dst, int nrows, LAS float* gs, LAS float* sh) {
    for (int r = F.wave; r < nrows; r += 8) {
        const GAS f32x4* xr = (const GAS f32x4*)(src + (size_t)r * DM) + F.lane;
        f32x4 v[4]; float s = 0.f;
#pragma unroll
        for (int j = 0; j < 4; ++j) { v[j] = xr[64 * j]; s += (v[j].x * v[j].x + v[j].y * v[j].y) + (v[j].z * v[j].z + v[j].w * v[j].w); }
        const float rstd = 1.0f / sqrtf(wave_sum(s) * (1.f / DM) + 1e-6f);
        GAS u32x2* o8 = (GAS u32x2*)(dst + (size_t)r * DM) + F.lane;
#pragma unroll
        for (int j = 0; j < 4; ++j) { const int c = 4 * F.lane + 256 * j; const f32x4 g = *(const LAS f32x4*)(gs + c), h = *(const LAS f32x4*)(sh + c);
            u32x2 w; w.x = pk2(v[j].x * rstd * g.x + h.x, v[j].y * rstd * g.y + h.y); w.y = pk2(v[j].z * rstd * g.z + h.z, v[j].w * rstd * g.w + h.w); o8[64 * j] = w; }
    }
}
__device__ __forceinline__ void p0b(Frame& F) {
    LAUNDER(F);
    float* MODF = (float*)(F.ws + WS_MODF);
    { const int gt = F.bid * 512 + F.tid; if (gt < 17 * NMOD) MODF[gt] = mod_val(F, gt / NMOD, gt % NMOD); }
    LAS float* gs = (LAS float*)F.lds; LAS float* sh = gs + DM;
    bf16_t* H = (bf16_t*)F.out;
    const int b = F.bid >> 4;
    for (int pass = 0; pass < 2; ++pass) {
        const int mb = pass == 0 ? b : 16;
        __syncthreads();
        for (int c = F.tid; c < DM; c += 512) { gs[c] = F.inp[I_N1G][c] * (1.0f + mod_val(F, mb, DM + c)); sh[c] = mod_val(F, mb, c); }
        __syncthreads();
        if (pass == 0) { const int r0 = b * SEQ + (F.bid & 15) * 128; h_rows(F, F.inp[I_X] + (size_t)r0 * DM, H + (size_t)r0 * DM, 128, gs, sh); }
        else { const int r0 = F.bid * 16; h_rows(F, F.inp[I_CTX] + (size_t)r0 * DM, H + (size_t)(NT + r0) * DM, 16, gs, sh); }
    }
}

__device__ __forceinline__ void rwkv_unit(Frame& F, int b, int h, int d) {
    LAUNDER(F);
    const int tid = F.tid, lane = F.lane, wave = F.wave;
    const bf16_t* CRW = (const bf16_t*)(F.ws + WS_CRW);
    bf16_t* YRW = (bf16_t*)F.out + (size_t)d * NT * 512;
    bf16_t* VCONV = (bf16_t*)(F.ws + WS_VCONV);
    float* CSC = (float*)(F.ws + WS_CSC) + (size_t)d * NT * 8;
    LAS float* L = (LAS float*)F.lds;
    LAS float* LA = L;
    LAS float* LW = L + 2048;
    LAS float* LB = L + 4096;
    LAS float* LK = L + 6144;
    LAS float* LR = L + 8192;
    LAS float* LV = L + 10240;
    LAS float* LY = L + 12288;
    LAS float* KT = L + 14336;
    LAS float* PW = L + 16384;
    LAS float* PA = L + 18432;
    LAS float* CW = L + 20480;
    for (int i = tid; i < 9 * 192; i += 512) { const int tap = i / 192, q = i % 192, which = q >> 6, c = q & 63; CW[i] = F.inp[I_CONV][tap * 1536 + which * 512 + h * 64 + c]; }
    const int ch = h * 64 + lane;
    const float p_kk = F.inp[I_KK][ch], p_ka = F.inp[I_KA][ch], p_rk = F.inp[I_RK][ch], p_w0 = F.inp[I_W0][d * 512 + ch], p_a0 = F.inp[I_A0][d * 512 + ch];
    bf16x8 bfrag[4];
    if (wave < 4) {
        const int arr = wave >> 1, ct = wave & 1; gcf Wl = F.inp[arr == 0 ? I_W2 : I_A2] + (size_t)d * 64 * 512;
        const int cc = h * 64 + ct * 32 + (lane & 31), hh = lane >> 5;
#pragma unroll
        for (int js = 0; js < 4; ++js) { bf16x8 t;
#pragma unroll
            for (int e = 0; e < 8; ++e) t[e] = (short)f2bf(Wl[(size_t)(16 * js + 8 * hh + e) * 512 + cc]);
            bfrag[js] = t; }
    }
    float s0[4] = {0.f, 0.f, 0.f, 0.f}, s1[4] = {0.f, 0.f, 0.f, 0.f};
    const int kq = tid & 15, P = tid >> 4;
    __syncthreads();
    for (int seg = 0; seg < 2; ++seg) {
        const int Ls = seg == 0 ? CTXL : SEQ, rowbase = seg == 0 ? NT + b * CTXL : b * SEQ, nchunk = Ls / TCS;
        for (int cidx = 0; cidx < nchunk; ++cidx) {
            const int t0 = d == 0 ? cidx * TCS : Ls - 1 - cidx * TCS, dir = d == 0 ? 1 : -1;
            for (int it = tid; it < TCS * 24; it += 512) {
                const int s = it / 24, gq = it % 24, which = gq >> 3, c0 = (gq & 7) * 8, t = t0 + dir * s;
                float o[8];
#pragma unroll
                for (int e = 0; e < 8; ++e) o[e] = 0.f;
                const int colb = which * 512 + h * 64 + c0;
                if (seg == 1) {
                    const int y = t >> 6, x = t & 63;
#pragma unroll
                    for (int dy = -1; dy <= 1; ++dy)
#pragma unroll
                        for (int dx = -1; dx <= 1; ++dx) {
                            const int yy = y + dy, xx = x + dx;
                            if (yy >= 0 && yy < 32 && xx >= 0 && xx < 64) {
                                const u32x4 raw = *(const u32x4*)(CRW + (size_t)(rowbase + yy * 64 + xx) * LD_RW + colb);
                                const LAS float* cw = CW + ((dy + 1) * 3 + (dx + 1)) * 192 + which * 64 + c0;
                                o[0] += bflo(raw.x) * cw[0]; o[1] += bfhi(raw.x) * cw[1]; o[2] += bflo(raw.y) * cw[2]; o[3] += bfhi(raw.y) * cw[3];
                                o[4] += bflo(raw.z) * cw[4]; o[5] += bfhi(raw.z) * cw[5]; o[6] += bflo(raw.w) * cw[6]; o[7] += bfhi(raw.w) * cw[7];
                            }
                        }
                } else {
#pragma unroll
                    for (int dx = -1; dx <= 1; ++dx) {
                        const int tt = t + dx;
                        if (tt >= 0 && tt < CTXL) {
                            const u32x4 raw = *(const u32x4*)(CRW + (size_t)(rowbase + tt) * LD_RW + colb);
                            const LAS float* cw = CW + (3 + (dx + 1)) * 192 + which * 64 + c0;
                            o[0] += bflo(raw.x) * cw[0]; o[1] += bfhi(raw.x) * cw[1]; o[2] += bflo(raw.y) * cw[2]; o[3] += bfhi(raw.y) * cw[3];
                            o[4] += bflo(raw.z) * cw[4]; o[5] += bfhi(raw.z) * cw[5]; o[6] += bflo(raw.w) * cw[6]; o[7] += bfhi(raw.w) * cw[7];
                        }
                    }
                }
                LAS float* dst = (which == 0 ? LR : (which == 1 ? KT : LV)) + s * 64 + c0;
                *(LAS f32x4*)dst = (f32x4){o[0], o[1], o[2], o[3]}; *(LAS f32x4*)(dst + 4) = (f32x4){o[4], o[5], o[6], o[7]};
            }
            if (wave < 4) {
                const int arr = wave >> 1, ct = wave & 1, sr = lane & 31, hh = lane >> 5, t = t0 + dir * sr;
                const bf16_t* rp = CRW + (size_t)(rowbase + t) * LD_RW + (arr == 0 ? 1536 : 1664) + d * 64 + 8 * hh;
                f32x16 acc;
#pragma unroll
                for (int i = 0; i < 16; ++i) acc[i] = 0.f;
#pragma unroll
                for (int js = 0; js < 4; ++js) {
                    u32x4 raw = *(const u32x4*)(rp + 16 * js);
                    if (arr == 0) {
                        float f[8] = {bflo(raw.x), bfhi(raw.x), bflo(raw.y), bfhi(raw.y), bflo(raw.z), bfhi(raw.z), bflo(raw.w), bfhi(raw.w)};
#pragma unroll
                        for (int e = 0; e < 8; ++e) f[e] = 1.0f - 2.0f / (1.0f + __expf(2.0f * f[e]));
                        raw.x = pk2(f[0], f[1]); raw.y = pk2(f[2], f[3]); raw.z = pk2(f[4], f[5]); raw.w = pk2(f[6], f[7]);
                    }
                    acc = __builtin_amdgcn_mfma_f32_32x32x16_bf16(__builtin_bit_cast(bf16x8, raw), bfrag[js], acc, 0, 0, 0);
                }
                LAS float* dstp = (arr == 0 ? PW : PA) + ct * 32 + (lane & 31);
#pragma unroll
                for (int i = 0; i < 16; ++i) { const int srow = (i & 3) + 8 * (i >> 2) + 4 * hh; dstp[srow * 64] = acc[i]; }
            }
            __syncthreads();
#pragma unroll
            for (int i = 0; i < 4; ++i) {
                const int s = 4 * wave + i, t = t0 + dir * s, idx = s * 64 + lane;
                const float k = KT[idx], r = LR[idx], af = sigmoidf_(PA[idx] + p_a0), sw = sigmoidf_(PW[idx] + p_w0);
                const float kkr = k * p_kk, ss = wave_sum(kkr * kkr), kk = kkr / fmaxf(sqrtf(ss), 1e-12f);
                const float kd = k * (1.0f + (af - 1.0f) * p_ka);
                LA[idx] = -kk; LB[idx] = kk * af; LK[idx] = kd; LW[idx] = __expf(-0.60653065971263342f * sw);
                if (seg == 1) {
                    const float cs = wave_sum(r * kd * p_rk);
                    if (lane == 0) CSC[(size_t)(rowbase + t) * 8 + h] = cs;
                    if (d == 0) VCONV[(size_t)(rowbase + t) * 512 + ch] = (bf16_t)f2bf(LV[idx]);
                }
            }
            __syncthreads();
#pragma unroll 2
            for (int s = 0; s < TCS; ++s) {
                const LAS float* base = L + s * 64;
                const f32x4 a = *(const LAS f32x4*)(base + 4 * kq), w = *(const LAS f32x4*)(base + 2048 + 4 * kq), bb = *(const LAS f32x4*)(base + 4096 + 4 * kq),
                            kd = *(const LAS f32x4*)(base + 6144 + 4 * kq), r = *(const LAS f32x4*)(base + 8192 + 4 * kq);
                const f32x2 vv = *(const LAS f32x2*)(base + 10240 + 2 * P);
                float sa0 = (s0[0] * a.x + s0[1] * a.y) + (s0[2] * a.z + s0[3] * a.w);
                float sa1 = (s1[0] * a.x + s1[1] * a.y) + (s1[2] * a.z + s1[3] * a.w);
                sa0 = row16_sum(sa0); sa1 = row16_sum(sa1);
                s0[0] = s0[0] * w.x + sa0 * bb.x + vv.x * kd.x; s0[1] = s0[1] * w.y + sa0 * bb.y + vv.x * kd.y; s0[2] = s0[2] * w.z + sa0 * bb.z + vv.x * kd.z; s0[3] = s0[3] * w.w + sa0 * bb.w + vv.x * kd.w;
                s1[0] = s1[0] * w.x + sa1 * bb.x + vv.y * kd.x; s1[1] = s1[1] * w.y + sa1 * bb.y + vv.y * kd.y; s1[2] = s1[2] * w.z + sa1 * bb.z + vv.y * kd.z; s1[3] = s1[3] * w.w + sa1 * bb.w + vv.y * kd.w;
                if (seg == 1) {
                    float y0 = (s0[0] * r.x + s0[1] * r.y) + (s0[2] * r.z + s0[3] * r.w);
                    float y1 = (s1[0] * r.x + s1[1] * r.y) + (s1[2] * r.z + s1[3] * r.w);
                    y0 = row16_sum(y0); y1 = row16_sum(y1);
                    if (kq == 0) *(LAS f32x2*)(LY + s * 64 + 2 * P) = (f32x2){y0, y1};
                }
            }
            __syncthreads();
            if (seg == 1) {
                const int s = tid >> 4, v0 = 4 * (tid & 15), t = t0 + dir * s;
                const f32x4 yv = *(const LAS f32x4*)(LY + s * 64 + v0);
                u32x2 w; w.x = pk2(yv.x, yv.y); w.y = pk2(yv.z, yv.w);
                *(u32x2*)(YRW + (size_t)(rowbase + t) * 512 + h * 64 + v0) = w;
            }
        }
    }
    __syncthreads();
}
__device__ __forceinline__ void hgrn_unit(Frame& F, int b, int h, int d) {
    LAUNDER(F);
    const int tid = F.tid;
    const bf16_t* CHG = (const bf16_t*)(F.ws + WS_CHG);
    bf16_t* OHG = (bf16_t*)F.out + (size_t)2 * NT * 512 + (size_t)d * NT * 512;
    LAS float* L = (LAS float*)F.lds;
    LAS float* LQ = L, *LF = L + 2048, *LKF = L + 4096, *LI = L + 6144, *LO = L + 8192;
    const int kq = tid & 15, P = tid >> 4;
    const int ps = tid >> 4, pc = 4 * (tid & 15);
    float lbv[4];
#pragma unroll
    for (int e = 0; e < 4; ++e) { const int ch = h * 64 + pc + e; lbv[e] = sigmoidf_(F.inp[I_LB][(d * 2 + 0) * 512 + ch] - F.inp[I_LB][(d * 2 + 1) * 512 + ch]); }
    float S0[4] = {0.f, 0.f, 0.f, 0.f}, S1[4] = {0.f, 0.f, 0.f, 0.f};
    __syncthreads();
    for (int seg = 0; seg < 2; ++seg) {
        const int Ls = seg == 0 ? CTXL : SEQ, rowbase = seg == 0 ? NT + b * CTXL : b * SEQ, nchunk = Ls / TCS;
        u32x2 rq, rf, ri;
        { const int t = d == 0 ? ps : Ls - 1 - ps; const bf16_t* rp = CHG + (size_t)(rowbase + t) * LD_HG + h * 64 + pc;
          rq = *(const u32x2*)rp; rf = *(const u32x2*)(rp + 512 + d * 512); ri = *(const u32x2*)(rp + 1536); }
        for (int cidx = 0; cidx < nchunk; ++cidx) {
            const int t0 = d == 0 ? cidx * TCS : Ls - 1 - cidx * TCS, dir = d == 0 ? 1 : -1;
            {
                const float q[4] = {bflo(rq.x), bfhi(rq.x), bflo(rq.y), bfhi(rq.y)}, f[4] = {bflo(rf.x), bfhi(rf.x), bflo(rf.y), bfhi(rf.y)}, iv[4] = {bflo(ri.x), bfhi(ri.x), bflo(ri.y), bfhi(ri.y)};
                f32x4 oq, of, ok, oi;
#pragma unroll
                for (int e = 0; e < 4; ++e) { const float sg = sigmoidf_(f[e]); oq[e] = siluf_(q[e]) * 0.125f; of[e] = lbv[e] + (1.0f - lbv[e]) * sg; ok[e] = (1.0f - lbv[e]) * (1.0f - sg); oi[e] = iv[e]; }
                const int idx = ps * 64 + pc;
                *(LAS f32x4*)(LQ + idx) = oq; *(LAS f32x4*)(LF + idx) = of; *(LAS f32x4*)(LKF + idx) = ok; *(LAS f32x4*)(LI + idx) = oi;
            }
            __syncthreads();
            if (cidx + 1 < nchunk) { const int t = t0 + dir * TCS + dir * ps; const bf16_t* rp = CHG + (size_t)(rowbase + t) * LD_HG + h * 64 + pc;
                rq = *(const u32x2*)rp; rf = *(const u32x2*)(rp + 512 + d * 512); ri = *(const u32x2*)(rp + 1536); }
#pragma unroll 4
            for (int s = 0; s < TCS; ++s) {
                const LAS float* base = L + s * 64;
                const f32x4 q = *(const LAS f32x4*)(base + 4 * kq), f = *(const LAS f32x4*)(base + 2048 + 4 * kq), kf = *(const LAS f32x4*)(base + 4096 + 4 * kq);
                const f32x2 iv = *(const LAS f32x2*)(base + 6144 + 2 * P);
                S0[0] = S0[0] * f.x + kf.x * iv.x; S0[1] = S0[1] * f.y + kf.y * iv.x; S0[2] = S0[2] * f.z + kf.z * iv.x; S0[3] = S0[3] * f.w + kf.w * iv.x;
                S1[0] = S1[0] * f.x + kf.x * iv.y; S1[1] = S1[1] * f.y + kf.y * iv.y; S1[2] = S1[2] * f.z + kf.z * iv.y; S1[3] = S1[3] * f.w + kf.w * iv.y;
                if (seg == 1) {
                    float o0 = (S0[0] * q.x + S0[1] * q.y) + (S0[2] * q.z + S0[3] * q.w);
                    float o1 = (S1[0] * q.x + S1[1] * q.y) + (S1[2] * q.z + S1[3] * q.w);
                    o0 = row16_sum(o0); o1 = row16_sum(o1);
                    if (kq == 0) *(LAS f32x2*)(LO + s * 64 + 2 * P) = (f32x2){o0, o1};
                }
            }
            __syncthreads();
            if (seg == 1) {
                const int s = tid >> 4, v0 = 4 * (tid & 15), t = t0 + dir * s;
                const f32x4 yv = *(const LAS f32x4*)(LO + s * 64 + v0);
                u32x2 w; w.x = pk2(yv.x, yv.y); w.y = pk2(yv.z, yv.w);
                *(u32x2*)(OHG + (size_t)(rowbase + t) * 512 + h * 64 + v0) = w;
            }
        }
    }
    __syncthreads();
}

__device__ __forceinline__ void post_tile(Frame& F, int tile) {
    LAUNDER(F);
    const int lane = F.lane, wave = F.wave;
    bf16_t* CRW = (bf16_t*)(F.ws + WS_CRW);
    const bf16_t* CHG = (const bf16_t*)(F.ws + WS_CHG);
    const bf16_t* G2T = (const bf16_t*)(F.ws + WS_G2T);
    const bf16_t* YRW = (const bf16_t*)F.out; const bf16_t* OHG = YRW + (size_t)2 * NT * 512;
    const bf16_t* VCONV = (const bf16_t*)(F.ws + WS_VCONV);
    const float* CSC = (const float*)(F.ws + WS_CSC);
    LAS float* LG = (LAS float*)F.lds;
    const int row0 = tile * 32;
    {
        const int sr = lane & 31, hh = lane >> 5;
        const bf16_t* rp = CRW + (size_t)(row0 + sr) * LD_RW + 1792 + 8 * hh;
        bf16x8 afr[8];
#pragma unroll
        for (int js = 0; js < 8; ++js) { const u32x4 raw = *(const u32x4*)(rp + 16 * js);
            float f[8] = {bflo(raw.x), bfhi(raw.x), bflo(raw.y), bfhi(raw.y), bflo(raw.z), bfhi(raw.z), bflo(raw.w), bfhi(raw.w)};
#pragma unroll
            for (int e = 0; e < 8; ++e) f[e] = sigmoidf_(f[e]);
            u32x4 o; o.x = pk2(f[0], f[1]); o.y = pk2(f[2], f[3]); o.z = pk2(f[4], f[5]); o.w = pk2(f[6], f[7]); afr[js] = __builtin_bit_cast(bf16x8, o); }
#pragma unroll
        for (int ci = 0; ci < 2; ++ci) {
            const int ct = 2 * wave + ci; const bf16_t* bp = G2T + (size_t)(ct * 32 + sr) * 128 + 8 * hh;
            f32x16 acc;
#pragma unroll
            for (int i = 0; i < 16; ++i) acc[i] = 0.f;
#pragma unroll
            for (int js = 0; js < 8; ++js) { const bf16x8 bfr = *(const bf16x8*)(bp + 16 * js); acc = __builtin_amdgcn_mfma_f32_32x32x16_bf16(afr[js], bfr, acc, 0, 0, 0); }
#pragma unroll
            for (int i = 0; i < 16; ++i) { const int srow = (i & 3) + 8 * (i >> 2) + 4 * hh; LG[srow * 512 + ct * 32 + sr] = acc[i]; }
        }
    }
    __syncthreads();
#pragma unroll 1
    for (int i = 0; i < 4; ++i) {
        const int tl = 4 * wave + i, row = row0 + tl, c0 = 8 * lane, hd = lane >> 3;
        const u32x4 ya = *(const u32x4*)(YRW + (size_t)row * 512 + c0), yb = *(const u32x4*)(YRW + (size_t)NT * 512 + (size_t)row * 512 + c0);
        float y[8] = {bflo(ya.x) + bflo(yb.x), bfhi(ya.x) + bfhi(yb.x), bflo(ya.y) + bflo(yb.y), bfhi(ya.y) + bfhi(yb.y), bflo(ya.z) + bflo(yb.z), bfhi(ya.z) + bfhi(yb.z), bflo(ya.w) + bflo(yb.w), bfhi(ya.w) + bfhi(yb.w)};
        float sm = 0.f;
#pragma unroll
        for (int e = 0; e < 8; ++e) sm += y[e];
        sm = oct_sum(sm);
        const float mu = sm * (1.f / 64.f);
        float sq = 0.f;
#pragma unroll
        for (int e = 0; e < 8; ++e) { const float dlt = y[e] - mu; sq += dlt * dlt; }
        sq = oct_sum(sq);
        const float rs = 1.0f / sqrtf(sq * (1.f / 64.f) + 64e-5f);
        const float cs = CSC[(size_t)row * 8 + hd] + CSC[(size_t)NT * 8 + (size_t)row * 8 + hd];
        const u32x4 vr = *(const u32x4*)(VCONV + (size_t)row * 512 + c0);
        const float vv[8] = {bflo(vr.x), bfhi(vr.x), bflo(vr.y), bfhi(vr.y), bflo(vr.z), bfhi(vr.z), bflo(vr.w), bfhi(vr.w)};
        float o[8];
#pragma unroll
        for (int e = 0; e < 8; ++e) { const float yn = (y[e] - mu) * rs * F.inp[I_LNG][c0 + e] + F.inp[I_LNB][c0 + e] + cs * vv[e]; o[e] = yn * LG[tl * 512 + c0 + e]; }
        u32x4 w1; w1.x = pk2(o[0], o[1]); w1.y = pk2(o[2], o[3]); w1.z = pk2(o[4], o[5]); w1.w = pk2(o[6], o[7]);
        const u32x4 oa = *(const u32x4*)(OHG + (size_t)row * 512 + c0), ob = *(const u32x4*)(OHG + (size_t)NT * 512 + (size_t)row * 512 + c0);
        float z[8] = {bflo(oa.x) + bflo(ob.x), bfhi(oa.x) + bfhi(ob.x), bflo(oa.y) + bflo(ob.y), bfhi(oa.y) + bfhi(ob.y), bflo(oa.z) + bflo(ob.z), bfhi(oa.z) + bfhi(ob.z), bflo(oa.w) + bflo(ob.w), bfhi(oa.w) + bfhi(ob.w)};
        float zq = 0.f;
#pragma unroll
        for (int e = 0; e < 8; ++e) zq += z[e] * z[e];
        zq = oct_sum(zq);
        const float zr = 1.0f / sqrtf(zq * (1.f / 64.f) + 1e-6f);
        const u32x4 gr = *(const u32x4*)(CHG + (size_t)row * LD_HG + 2048 + c0);
        const float gg[8] = {bflo(gr.x), bfhi(gr.x), bflo(gr.y), bfhi(gr.y), bflo(gr.z), bfhi(gr.z), bflo(gr.w), bfhi(gr.w)};
        float p[8];
#pragma unroll
        for (int e = 0; e < 8; ++e) p[e] = z[e] * zr * F.inp[I_HGN][(c0 + e) & 63] * siluf_(gg[e]);
        u32x4 w2; w2.x = pk2(p[0], p[1]); w2.y = pk2(p[2], p[3]); w2.z = pk2(p[4], p[5]); w2.w = pk2(p[6], p[7]);
        *(u32x4*)(CRW + (size_t)row * LD_RW + c0) = w1;
        *(u32x4*)(CRW + (size_t)row * LD_RW + 512 + c0) = w2;
    }
    __syncthreads();
}

__device__ __forceinline__ void route_phase(Frame& F) {
    LAUNDER(F);
    const int tid = F.tid, lane = F.lane, wave = F.wave, bid = F.bid;
    const float* X1 = F.out; const float* MODF = (const float*)(F.ws + WS_MODF); const float* RWT = (const float*)(F.ws + WS_RWT);
    bf16_t* H2 = (bf16_t*)(F.ws + WS_H2);
    int* SLOT = (int*)(F.ws + WS_SLOT); float* GATE = (float*)(F.ws + WS_GATE); int* TOKL = (int*)(F.ws + WS_TOKL);
    const int tok0 = bid * 128, b = bid >> 4, chunk = bid >> 6;
    LAS float* gs = (LAS float*)F.lds;
    LAS float* sh = gs + 1024;
    LAS float* rs = gs + 2048;
    LAS float* LGT = gs + 2304;
    LAS int* lcnt = (LAS int*)(gs + 2304 + 128 * 65);
    LAS int* gbase = lcnt + 64;
    LAS int* lsl = gbase + 64;
    for (int c = tid; c < DM; c += 512) { gs[c] = F.inp[I_N2G][c] * (1.0f + MODF[(size_t)b * NMOD + 4 * DM + c]); sh[c] = MODF[(size_t)b * NMOD + 3 * DM + c]; }
    if (tid < 64) lcnt[tid] = 0;
    __syncthreads();
    for (int r = wave; r < 128; r += 8) {
        const GAS f32x4* xr = (const GAS f32x4*)(X1 + (size_t)(tok0 + r) * DM) + lane;
        f32x4 v[4]; float s = 0.f;
#pragma unroll
        for (int j = 0; j < 4; ++j) { v[j] = xr[64 * j]; s += (v[j].x * v[j].x + v[j].y * v[j].y) + (v[j].z * v[j].z + v[j].w * v[j].w); }
        const float rstd = 1.0f / sqrtf(wave_sum(s) * (1.f / DM) + 1e-6f);
        if (lane == 0) rs[r] = rstd;
        GAS u32x2* o8 = (GAS u32x2*)(H2 + (size_t)(tok0 + r) * DM) + lane;
#pragma unroll
        for (int j = 0; j < 4; ++j) { const int c = 4 * lane + 256 * j; const f32x4 g = *(const LAS f32x4*)(gs + c), h = *(const LAS f32x4*)(sh + c);
            u32x2 w; w.x = pk2(v[j].x * rstd * g.x + h.x, v[j].y * rstd * g.y + h.y); w.y = pk2(v[j].z * rstd * g.z + h.z, v[j].w * rstd * g.w + h.w); o8[64 * j] = w; }
    }
    __syncthreads();
    {
        const int tt = wave >> 1, et = wave & 1, i = lane & 31, kk = lane >> 5;
        const float* xa = X1 + (size_t)(tok0 + tt * 32 + i) * DM + 512 * kk;
        const float* wb = RWT + (size_t)(et * 32 + i) * DM + 512 * kk;
        const float rstd = rs[tt * 32 + i];
        f32x16 acc;
#pragma unroll
        for (int q = 0; q < 16; ++q) acc[q] = 0.f;
#pragma unroll 4
        for (int ks = 0; ks < 512; ks += 4) {
            const f32x4 xv = *(const f32x4*)(xa + ks), wv = *(const f32x4*)(wb + ks);
            const f32x4 g = *(const LAS f32x4*)(gs + 512 * kk + ks), h = *(const LAS f32x4*)(sh + 512 * kk + ks);
            const f32x4 hv = xv * rstd * g + h;
            acc = __builtin_amdgcn_mfma_f32_32x32x2f32(hv.x, wv.x, acc, 0, 0, 0);
            acc = __builtin_amdgcn_mfma_f32_32x32x2f32(hv.y, wv.y, acc, 0, 0, 0);
            acc = __builtin_amdgcn_mfma_f32_32x32x2f32(hv.z, wv.z, acc, 0, 0, 0);
            acc = __builtin_amdgcn_mfma_f32_32x32x2f32(hv.w, wv.w, acc, 0, 0, 0);
        }
#pragma unroll
        for (int q = 0; q < 16; ++q) { const int trow = (q & 3) + 8 * (q >> 2) + 4 * kk; LGT[(tt * 32 + trow) * 65 + et * 32 + i] = acc[q]; }
    }
    __syncthreads();
    const float rbias = F.inp[I_RB][lane];
    for (int r = wave; r < 128; r += 8) {
        const float score = sigmoidf_(LGT[r * 65 + lane]);
        const float sel = score + rbias;
        const float m1 = oct_max(sel);
        const int i1 = oct_min((sel == m1) ? (lane & 7) : 99);
        const float m2 = oct_max(((lane & 7) == i1) ? -INFINITY : sel);
        const float gsc = m1 + m2;
        const int gme = lane >> 3; int rank = 0;
#pragma unroll
        for (int gq = 0; gq < 8; ++gq) { const float og = rdl(gsc, gq * 8); rank += (og > gsc || (og == gsc && gq < gme)) ? 1 : 0; }
        float msk = (rank < 4) ? sel : -INFINITY;
        bool chosen = false; int myj = 0;
#pragma unroll 1
        for (int j = 0; j < 8; ++j) {
            const float mx = wave_max(msk);
            const unsigned long long bal = __ballot(msk == mx);
            const int win = __ffsll((long long)bal) - 1;
            if (lane == win) { chosen = true; myj = j; msk = -INFINITY; }
        }
        const float gsum = wave_sum(chosen ? score : 0.f);
        if (chosen) {
            const float gate = score / gsum * 2.5f;
            const int lpos = atomicAdd((int*)&lcnt[lane], 1);
            lsl[r * 8 + myj] = lane | (lpos << 8);
            GATE[(size_t)(tok0 + r) * 8 + myj] = gate;
        }
    }
    __syncthreads();
    if (tid < 64) gbase[tid] = (int)__hip_atomic_fetch_add((unsigned*)(F.ctl + CW_GCNT) + chunk * 64 + tid, (unsigned)lcnt[tid], RLX_AGENT);
    __syncthreads();
    for (int q = tid; q < 128 * 8; q += 512) {
        const int v = lsl[q], e = v & 255, pos = gbase[e] + (v >> 8), r = q >> 3;
        TOKL[((size_t)chunk * 64 + e) * CAPE + pos] = tok0 + r;
        SLOT[(size_t)(tok0 + r) * 8 + (q & 7)] = e | (pos << 8);
    }
    __syncthreads();
}

__device__ __forceinline__ void moe_tables(Frame& F, int chunk, LAS int* tb) {
    if (F.tid < 65) tb[F.tid] = F.tid < 64 ? (int)__hip_atomic_load((unsigned*)(F.ctl + CW_GCNT) + chunk * 64 + F.tid, RLX_AGENT) : TCH;
    __syncthreads();
    if (F.tid == 0) {
        int ro = 0, bp = 0;
#pragma unroll 1
        for (int e = 0; e < 65; ++e) { const int nb = (tb[e] + 255) >> 8; tb[72 + e] = ro; tb[144 + e] = bp; ro += nb * 256; bp += nb; }
        tb[72 + 65] = ro; tb[144 + 65] = bp;
    }
    __syncthreads();
}
__device__ __forceinline__ int moe_units(Frame& F, int chunk, int npn, bool g1, LAS int* tb, LAS int* ul) {
    const int nblk = tb[144 + 65], nun = nblk * npn;
    const int G = F.G, c = F.bid;
    const int n = (nun > c) ? (nun - c + G - 1) / G : 0;
    if (F.tid < n) {
        int wg = F.tid * G + c;
        { const int q = nun / 8, r = nun % 8, xcd = wg % 8, off = wg / 8; wg = (xcd < r ? xcd * (q + 1) : r * (q + 1) + (xcd - r) * q) + off; }
        const int bg = wg / npn, pn = wg % npn;
        int e = 0;
#pragma unroll 1
        while (e < 64 && tb[144 + e + 1] <= bg) ++e;
        const int blk = bg - tb[144 + e], cnt = tb[e], nvalid = min(256, cnt - blk * 256), orow = tb[72 + e] + blk * 256;
        LAS int* p = ul + F.tid * 8;
        if (g1) { p[0] = chunk * TCH + blk * 256; p[1] = e * 512 + pn * 256; p[2] = (e < 64) ? ((chunk * 64 + e) * CAPE + blk * 256) : -1; p[3] = nvalid; p[4] = orow; p[5] = pn; p[6] = e; p[7] = 0; }
        else { p[0] = orow; p[1] = e * 1024 + pn * 256; p[2] = 0; p[3] = 256; p[4] = orow; p[5] = pn; p[6] = e; p[7] = 0; }
    }
    __syncthreads();
    return n;
}
__device__ __forceinline__ void combine_chunk(Frame& F, int chunk, LAS int* tb) {
    LAUNDER(F);
    const int lane = F.lane, wave = F.wave;
    const bf16_t* Y = (const bf16_t*)(F.ws + WS_Y);
    const int* SLOT = (const int*)(F.ws + WS_SLOT); const float* GATE = (const float*)(F.ws + WS_GATE); const float* MODF = (const float*)(F.ws + WS_MODF);
    float* X1 = F.out;
    for (int r = wave; r < 32; r += 8) {
        const int tok = chunk * TCH + F.bid * 32 + r, b = tok >> 11;
        f32x4 acc[4];
#pragma unroll
        for (int j = 0; j < 4; ++j) acc[j] = (f32x4){0.f, 0.f, 0.f, 0.f};
#pragma unroll 3
        for (int j = 0; j < 9; ++j) {
            int rowi; float gate;
            if (j < 8) { const int v = SLOT[(size_t)tok * 8 + j]; rowi = tb[72 + (v & 255)] + (v >> 8); gate = GATE[(size_t)tok * 8 + j]; }
            else { rowi = tb[72 + 64] + (tok - chunk * TCH); gate = 1.0f; }
            const GAS u32x2* yr = (const GAS u32x2*)(Y + (size_t)rowi * DM) + lane;
#pragma unroll
            for (int q = 0; q < 4; ++q) { const u32x2 w = yr[64 * q]; acc[q].x += gate * bflo(w.x); acc[q].y += gate * bfhi(w.x); acc[q].z += gate * bflo(w.y); acc[q].w += gate * bfhi(w.y); }
        }
        GAS f32x4* xr = (GAS f32x4*)(X1 + (size_t)tok * DM) + lane;
        const f32x4* g2 = (const f32x4*)(MODF + (size_t)b * NMOD + 5 * DM) + lane;
        f32x4 v[4]; float s = 0.f;
#pragma unroll
        for (int q = 0; q < 4; ++q) { v[q] = xr[64 * q] + g2[64 * q] * acc[q]; s += (v[q].x * v[q].x + v[q].y * v[q].y) + (v[q].z * v[q].z + v[q].w * v[q].w); }
        const float rstd = 1.0f / sqrtf(wave_sum(s) * (1.f / DM) + 1e-6f);
        const GAS f32x4* fg = (const GAS f32x4*)F.inp[I_FNG] + lane;
#pragma unroll
        for (int q = 0; q < 4; ++q) xr[64 * q] = v[q] * rstd * fg[64 * q];
    }
}

constexpr int NPHASE = 16;
struct Args { const float* in[32]; float* out; unsigned char* ws; int ph_lo, ph_hi, li, pad; };
__global__ void __launch_bounds__(512, 2) fwd_kernel(Args args) {
    extern __shared__ __attribute__((aligned(16))) unsigned char lds[];
    Frame F;
    F.lds = (LAS unsigned char*)lds;
    F.MISC = (volatile LAS unsigned*)(F.lds + MISC_OFF);
    F.tid = threadIdx.x; F.lane = F.tid & 63; F.wave = __builtin_amdgcn_readfirstlane(F.tid >> 6);
    F.G = gridDim.x; F.bid = blockIdx.x;
    F.inp = (const gcf __attribute__((address_space(4)))*)__builtin_amdgcn_kernarg_segment_ptr();
    F.out = args.out; F.ws = args.ws;
    F.ctl = (gu32*)(args.ws + WS_CTL);
    for (int u = F.tid; u < (LDS_BYTES - LDSCTL_OFF) / 4; u += 512) ((LAS unsigned*)(F.lds + LDSCTL_OFF))[u] = 0u;
    __syncthreads();
    XcdBarrier bar; bar.bar = (unsigned*)(F.ctl + CW_BAR); bar.x = 0; bar.st = nullptr;
    if (MK_N_LAUNCHES == 1) bar = xcd_barrier_post((unsigned*)(F.ctl + CW_BAR), F.MISC + 8);
    const int lo = args.ph_lo, hi = args.ph_hi;
    LAS int* tb = (LAS int*)(F.lds + TBL_OFF);
    LAS int* ul = tb + 256;
#ifndef PH_MASK
#define PH_MASK 0xFFFF
#endif
#pragma unroll 1
    for (int ph = lo; ph < hi; ++ph) {
        LAUNDER(F);
        { int tid_ = threadIdx.x; asm volatile("" : "+v"(tid_)); F.tid = tid_; F.lane = tid_ & 63; F.wave = __builtin_amdgcn_readfirstlane(tid_ >> 6);
          int bid_ = blockIdx.x, g_ = gridDim.x; asm volatile("" : "+s"(bid_), "+s"(g_)); F.bid = bid_; F.G = g_; }
        const int phm = ph;
#define PHB(k) ((PH_MASK >> (k)) & 1)
        if (phm == 0 && PHB(0)) { p0a(F); }
        else if (phm == 1 && PHB(1)) { p0b(F); }
        else if (phm == 2 && PHB(2)) {
            pg8::Gemm g{(const bf16_t*)F.out, (const bf16_t*)(F.ws + WS_WIN), nullptr, DM, DM}; pg8::StaticOrder S; S.init(MROWS, N_IN, F.G, F.bid);
            pg8::EpiCols E{(bf16_t*)(F.ws + WS_CRW), (bf16_t*)(F.ws + WS_CHG)};
            pg8::gemm_phase<pg8::EpiCols, pg8::StaticOrder, false, true>(F.lds, g, S, E, F.tid);
        }
        else if (phm == 3 && PHB(3)) {
#pragma unroll 1
            for (int u = F.bid; u < 256; u += F.G) { rwkv_unit(F, u >> 4, (u >> 1) & 7, u & 1); hgrn_unit(F, u >> 4, (u >> 1) & 7, u & 1); }
        }
        else if (phm == 4 && PHB(4)) {
#pragma unroll 1
            for (int t = F.bid; t < NT / 32; t += F.G) post_tile(F, t);
        }
        else if (phm == 5 && PHB(5)) {
            pg8::Gemm g{(const bf16_t*)(F.ws + WS_CRW), (const bf16_t*)(F.ws + WS_WOUT), nullptr, LD_RW, DM}; pg8::StaticOrder S; S.init(NT, DM, F.G, F.bid);
            pg8::EpiX1 E{F.inp[I_X], (const float*)(F.ws + WS_MODF), F.out};
            pg8::gemm_phase<pg8::EpiX1, pg8::StaticOrder, false, true>(F.lds, g, S, E, F.tid);
        }
        else if (phm == 6 && PHB(6)) { route_phase(F); }
        else if (phm >= 7) {
            const bool odd = (phm & 1) != 0;
            if (odd && phm >= 9 && PHB(9)) {
                const int c = (phm - 9) >> 1;
                __syncthreads();
                moe_tables(F, c, tb);
                combine_chunk(F, c, tb);
                __syncthreads();
            }
            if (odd && phm <= 13 && PHB(7)) {
                const int c = (phm - 7) >> 1;
                LAUNDER(F);
                __syncthreads();
                moe_tables(F, c, tb);
                const int n = moe_units(F, c, 2, true, tb, ul);
                pg8::Gemm g{(const bf16_t*)(F.ws + WS_H2), (const bf16_t*)(F.ws + WS_W1E), (const int*)(F.ws + WS_TOKL), DM, DM};
                pg8::ListOrder S{ul, n}; pg8::EpiSwiglu E{(bf16_t*)(F.ws + WS_ACT)};
                pg8::gemm_phase<pg8::EpiSwiglu, pg8::ListOrder, true, true>(F.lds, g, S, E, F.tid);
            }
            if (!odd && PHB(8)) {
                const int c = (phm - 8) >> 1;
                __syncthreads();
                moe_tables(F, c, tb);
                const int n = moe_units(F, c, 4, false, tb, ul);
                pg8::Gemm g{(const bf16_t*)(F.ws + WS_ACT), (const bf16_t*)(F.ws + WS_W2E), nullptr, 256, 256};
                pg8::ListOrder S{ul, n}; pg8::EpiBf E{(bf16_t*)(F.ws + WS_Y), DM};
                pg8::gemm_phase<pg8::EpiBf, pg8::ListOrder, false, true>(F.lds, g, S, E, F.tid);
            }
        }
        if (ph + 1 < hi) xcd_barrier(bar);
    }
}

extern "C" void kernel_launch(void* const* d_in, const int* in_sizes, int n_in, void* d_out, int out_size, void* d_ws, size_t ws_size, hipStream_t stream) {
    static int grid = 0;
    if (grid == 0) {
        if (n_in != 32 || out_size != NT * DM || ws_size < WS_END) { fprintf(stderr, "kernel_launch: unexpected shapes: n_in %d out %d ws %zu\n", n_in, out_size, ws_size); grid = -1; return; }
        int dev = 0, cus = 0, per_cu = 0;
        if (hipGetDevice(&dev) != hipSuccess || hipDeviceGetAttribute(&cus, hipDeviceAttributeMultiprocessorCount, dev) != hipSuccess) { grid = -1; return; }
        if (hipFuncSetAttribute((const void*)fwd_kernel, hipFuncAttributeMaxDynamicSharedMemorySize, LDS_BYTES) != hipSuccess) { fprintf(stderr, "kernel_launch: hipFuncSetAttribute failed\n"); grid = -1; return; }
        if (hipOccupancyMaxActiveBlocksPerMultiprocessor(&per_cu, (const void*)fwd_kernel, 512, LDS_BYTES) != hipSuccess || per_cu < 1)
            fprintf(stderr, "kernel_launch: occupancy query reports %d workgroups per CU\n", per_cu);
        (void)hipGetLastError();
        grid = cus;
        if (grid != 256) fprintf(stderr, "kernel_launch: %d CUs (built for 256)\n", grid);
    }
    if (grid < 0) return;
    if (hipMemsetAsync((char*)d_ws + WS_CTL, 0, CTL_ZERO_BYTES, stream) != hipSuccess) { fprintf(stderr, "kernel_launch: memset failed\n"); return; }
    Args a{};
    for (int i = 0; i < 32; ++i) a.in[i] = (const float*)d_in[i];
    a.out = (float*)d_out; a.ws = (unsigned char*)d_ws;
    if (MK_N_LAUNCHES == 1) {
        a.ph_lo = 0; a.ph_hi = NPHASE; a.li = 0;
        hipLaunchKernelGGL(fwd_kernel, dim3(grid), dim3(512), LDS_BYTES, stream, a);
    } else {
        for (int p = 0; p < NPHASE; ++p) { a.ph_lo = p; a.ph_hi = p + 1; a.li = p; hipLaunchKernelGGL(fwd_kernel, dim3(grid), dim3(512), LDS_BYTES, stream, a); }
    }
    const hipError_t le = hipPeekAtLastError();
    if (le != hipSuccess) fprintf(stderr, "kernel_launch: launch failed: %s\n", hipGetErrorName(le));
}
```

```cpp
#include <hip/hip_runtime.h>
#include <cstdio>
#include <cstdint>

#ifndef MK_N_LAUNCHES
#define MK_N_LAUNCHES 1
#endif

#define GAS __attribute__((address_space(1)))
#define LAS __attribute__((address_space(3)))
typedef unsigned short bf16_t;
typedef short bf16x8 __attribute__((ext_vector_type(8)));
typedef float f32x4 __attribute__((ext_vector_type(4)));
typedef float f32x2 __attribute__((ext_vector_type(2)));
typedef float f32x16 __attribute__((ext_vector_type(16)));
typedef unsigned u32x4 __attribute__((ext_vector_type(4)));
typedef unsigned u32x2 __attribute__((ext_vector_type(2)));
typedef GAS unsigned gu32;
typedef const GAS float* gcf;

constexpr int NB = 16, SEQ = 2048, DM = 1024, CTXL = 256, NT = NB * SEQ, NTC = NB * CTXL, MROWS = NT + NTC;
constexpr int LD_RW = 2048, LD_HG = 2560, N_IN = 4608, P_IN = 4480;
constexpr int NEXP = 64, NCH = 2, TCH = NT / NCH, CAPE = TCH;
constexpr int NMOD = 6 * DM;
constexpr int TCS = 32;
constexpr int ROWS_CH = 164096;

constexpr size_t MiB = 1u << 20;
constexpr size_t WS_CTL = 0, CTL_ZERO_BYTES = 1 * MiB;
constexpr size_t WS_MODF = 1 * MiB;
constexpr size_t WS_MODP = 2 * MiB;
constexpr size_t WS_RWT = 9 * MiB;
constexpr size_t WS_G2T = 9 * MiB + 512 * 1024;
constexpr size_t WS_WIN = 10 * MiB;
constexpr size_t WS_WOUT = 19 * MiB;
constexpr size_t WS_W1E = 21 * MiB;
constexpr size_t WS_W2E = 86 * MiB;
constexpr size_t WS_SLOT = 119 * MiB;
constexpr size_t WS_GATE = 120 * MiB;
constexpr size_t WS_TOKL = 121 * MiB;
constexpr size_t WS_BIG = 130 * MiB;
constexpr size_t WS_CRW = WS_BIG;
constexpr size_t WS_CHG = WS_BIG + 144 * MiB;
constexpr size_t WS_VCONV = WS_BIG + 324 * MiB;
constexpr size_t WS_CSC = WS_BIG + 356 * MiB;
constexpr size_t WS_H2 = WS_BIG;
constexpr size_t WS_ACT = WS_BIG + 64 * MiB;
constexpr size_t WS_Y = WS_BIG + 146 * MiB;
constexpr size_t WS_X1B = WS_BIG + 308 * MiB;
constexpr size_t WS_END = 512 * MiB;
static_assert(WS_X1B >= WS_Y + (size_t)ROWS_CH * 1024 && WS_X1B + (size_t)NT * DM * 2 <= WS_END && WS_CSC + 2 * MiB <= WS_END && WS_Y + (size_t)ROWS_CH * 1024 <= WS_END && WS_ACT + (size_t)ROWS_CH * 512 <= WS_Y, "ws map");
constexpr int CW_TMO = 0, CW_CODE = 1, CW_BAR = 4096, CW_GCNT = 16384, CW_TS = 20480;
#ifndef DUP_PH
#define DUP_PH -1
#endif
#ifndef RW_CHUNKED
#define RW_CHUNKED 1
#endif
#ifndef DUP_MODE
#define DUP_MODE 0
#endif
#ifndef PROBE_K
#define PROBE_K -1
#endif

constexpr int RING_BYTES = 131072;
constexpr int LDSCTL_OFF = RING_BYTES, MISC_OFF = LDSCTL_OFF + 320, TBL_OFF = LDSCTL_OFF + 1024;
constexpr int LDS_BYTES = 147456;

#define RLX_AGENT __ATOMIC_RELAXED, __HIP_MEMORY_SCOPE_AGENT
#define LDS_WAIT() asm volatile("s_waitcnt lgkmcnt(0)" ::: "memory")
#define VM_WAIT() asm volatile("s_waitcnt vmcnt(0)" ::: "memory")
#define LDS_BARRIER() do { asm volatile("s_waitcnt lgkmcnt(0)" ::: "memory"); __builtin_amdgcn_s_barrier(); asm volatile("" ::: "memory"); } while (0)
__device__ __forceinline__ unsigned f2bf(float f) { unsigned u = __builtin_bit_cast(unsigned, f); return (u + 0x7fffu + ((u >> 16) & 1u)) >> 16; }
__device__ __forceinline__ unsigned pk2(float lo, float hi) { return f2bf(lo) | (f2bf(hi) << 16); }
__device__ __forceinline__ float bf2f(unsigned short h) { return __builtin_bit_cast(float, (unsigned)h << 16); }
__device__ __forceinline__ float bflo(unsigned w) { return __builtin_bit_cast(float, w << 16); }
__device__ __forceinline__ float bfhi(unsigned w) { return __builtin_bit_cast(float, w & 0xffff0000u); }
__device__ __forceinline__ float sigmoidf_(float x) { return 1.0f / (1.0f + __expf(-x)); }
__device__ __forceinline__ float siluf_(float x) { return x / (1.0f + __expf(-x)); }
typedef __bf16 bf16x2_t __attribute__((ext_vector_type(2)));
__device__ __forceinline__ unsigned cvtpk(float lo, float hi) { const f32x2 v = {lo, hi}; const bf16x2_t b = __builtin_convertvector(v, bf16x2_t); return __builtin_bit_cast(unsigned, b); }
__device__ __forceinline__ unsigned short cvt1(float x) { return (unsigned short)(cvtpk(x, 0.f) & 0xffffu); }
__device__ __forceinline__ float fexp(float x) { return __builtin_amdgcn_exp2f(x * 1.4426950408889634f); }
__device__ __forceinline__ float fsigmoid(float x) { return __builtin_amdgcn_rcpf(1.0f + fexp(-x)); }
__device__ __forceinline__ float fsilu(float x) { return x * fsigmoid(x); }
__device__ __forceinline__ float ftanh(float x) { return 1.0f - 2.0f * __builtin_amdgcn_rcpf(1.0f + fexp(2.0f * x)); }
template <int CTRL> __device__ __forceinline__ float dppf(float x) { return __builtin_bit_cast(float, __builtin_amdgcn_update_dpp(0, __builtin_bit_cast(int, x), CTRL, 0xf, 0xf, true)); }
__device__ __forceinline__ float row16_sum(float x) {
    x += dppf<0xB1>(x);
    x += dppf<0x4E>(x);
    x += dppf<0x141>(x);
    x += dppf<0x140>(x);
    return x;
}
__device__ __forceinline__ float row16_max(float x) {
    x = fmaxf(x, dppf<0xB1>(x)); x = fmaxf(x, dppf<0x4E>(x)); x = fmaxf(x, dppf<0x141>(x)); x = fmaxf(x, dppf<0x140>(x));
    return x;
}
__device__ __forceinline__ float rdl(float x, int l) { return __builtin_bit_cast(float, __builtin_amdgcn_readlane(__builtin_bit_cast(int, x), l)); }
__device__ __forceinline__ float wave_sum(float v) { v = row16_sum(v); return (rdl(v, 0) + rdl(v, 16)) + (rdl(v, 32) + rdl(v, 48)); }
__device__ __forceinline__ float wave_max(float v) { v = row16_max(v); return fmaxf(fmaxf(rdl(v, 0), rdl(v, 16)), fmaxf(rdl(v, 32), rdl(v, 48))); }
__device__ __forceinline__ float oct_sum(float x) { x += dppf<0xB1>(x); x += dppf<0x4E>(x); x += dppf<0x141>(x); return x; }
__device__ __forceinline__ float oct_max(float x) { x = fmaxf(x, dppf<0xB1>(x)); x = fmaxf(x, dppf<0x4E>(x)); x = fmaxf(x, dppf<0x141>(x)); return x; }
__device__ __forceinline__ int oct_min(int x) {
    x = min(x, __builtin_amdgcn_update_dpp(0, x, 0xB1, 0xf, 0xf, true)); x = min(x, __builtin_amdgcn_update_dpp(0, x, 0x4E, 0xf, 0xf, true)); x = min(x, __builtin_amdgcn_update_dpp(0, x, 0x141, 0xf, 0xf, true));
    return x;
}

__device__ __forceinline__ float fmul_s(float a, float b) { float r; asm("v_mul_f32_e32 %0, %1, %2" : "=v"(r) : "v"(a), "v"(b)); return r; }
__device__ __forceinline__ float ffma_s(float a, float b, float c) { asm("v_fmac_f32_e32 %0, %1, %2" : "+v"(c) : "v"(a), "v"(b)); return c; }
__device__ __forceinline__ void row16_sum2(float& a, float& b) {
    asm("s_nop 1\n\t"
        "v_add_f32_dpp %0, %0, %0 quad_perm:[1,0,3,2] row_mask:0xf bank_mask:0xf bound_ctrl:1\n\t"
        "v_add_f32_dpp %1, %1, %1 quad_perm:[1,0,3,2] row_mask:0xf bank_mask:0xf bound_ctrl:1\n\t"
        "s_nop 0\n\t"
        "v_add_f32_dpp %0, %0, %0 quad_perm:[2,3,0,1] row_mask:0xf bank_mask:0xf bound_ctrl:1\n\t"
        "v_add_f32_dpp %1, %1, %1 quad_perm:[2,3,0,1] row_mask:0xf bank_mask:0xf bound_ctrl:1\n\t"
        "s_nop 0\n\t"
        "v_add_f32_dpp %0, %0, %0 row_half_mirror row_mask:0xf bank_mask:0xf bound_ctrl:1\n\t"
        "v_add_f32_dpp %1, %1, %1 row_half_mirror row_mask:0xf bank_mask:0xf bound_ctrl:1\n\t"
        "s_nop 0\n\t"
        "v_add_f32_dpp %0, %0, %0 row_mirror row_mask:0xf bank_mask:0xf bound_ctrl:1\n\t"
        "v_add_f32_dpp %1, %1, %1 row_mirror row_mask:0xf bank_mask:0xf bound_ctrl:1\n\t"
        "s_nop 0"
        : "+v"(a), "+v"(b));
}

namespace pg8 {
constexpr int BM = 256, BK = 64, HALF = 128, HTB = HALF * BK * 2, STAGE_BYTES = 8 * HTB, NXCD = 8, WGM = 8;
__host__ __device__ __forceinline__ int lds_byte(int r, int c) { const int st = (r >> 4) * 2 + (c >> 5), rr = r & 15, cc = c & 31, ob = rr * 64 + cc * 2; return st * 1024 + (ob ^ (((ob >> 9) & 1) << 5)); }
__host__ __device__ __forceinline__ void stage_rc(int b, int& R, int& C) { const int st = b / 1024, sb = b % 1024, swz = sb ^ (((sb >> 9) & 1) << 5); R = (st >> 1) * 16 + swz / 64; C = (st & 1) * 32 + (swz % 64) / 2; }
__host__ __device__ __forceinline__ int perm32(int rho) { const int n = rho >> 4, i = rho & 15; return 8 * (i >> 2) + 4 * n + (i & 3); }

struct Unit { int arow, brow, gofs, nvalid, orow, pn; };
struct Gemm { const bf16_t* A; const bf16_t* Bt; const int* gidx; int lda; int K; };

struct StaticOrder {
    int nM, nN, nwg, G, c;
    __device__ void init(int M, int N, int G_, int c_) { nM = M / BM; nN = N / BM; nwg = nM * nN; G = G_; c = c_; }
    __device__ bool next(int i, Unit& u) const {
        const long L = (long)i * G + c; if (L >= nwg) return false;
        int wgid = (int)L; { const int q = nwg / NXCD, r = nwg % NXCD, xcd = wgid % NXCD, off = wgid / NXCD; wgid = (xcd < r ? xcd * (q + 1) : r * (q + 1) + (xcd - r) * q) + off; }
        const int nig = WGM * nN, gid = wgid / nig, fm = gid * WGM, gsz = (nM - fm) < WGM ? (nM - fm) : WGM;
        const int pm = fm + ((wgid % nig) % gsz), pn = (wgid % nig) / gsz;
        u.arow = pm * BM; u.brow = pn * BM; u.gofs = 0; u.nvalid = BM; u.orow = pm * BM; u.pn = pn; return true;
    }
};
struct InProjOrder {
    StaticOrder lat; int G, c;
    __device__ void init(int G_, int c_) { lat.init(NT, N_IN, G_, c_); G = G_; c = c_; }
    __device__ bool next(int i, Unit& u) const {
        const int L = i * G + c, nlat = (NT / BM) * (N_IN / BM);
        if (L < nlat) return lat.next(i, u);
        const int Lc = L - nlat; if (Lc >= 16 * 11) return false;
        const int pm = NT / BM + Lc / 11, q = Lc % 11, pn = q < 5 ? q + 2 : q + 5;
        u.arow = pm * BM; u.brow = pn * BM; u.gofs = 0; u.nvalid = BM; u.orow = pm * BM; u.pn = pn; return true;
    }
};
struct ListOrder {
    const LAS int* ul; int n;
    __device__ bool next(int i, Unit& u) const {
        if (i >= n) return false;
        const LAS int* p = ul + i * 8;
        u.arow = p[0]; u.brow = p[1]; u.gofs = p[2]; u.nvalid = p[3]; u.orow = p[4]; u.pn = p[5]; return true;
    }
};

__device__ __forceinline__ unsigned cvt_pk_bf16(float lo, float hi) { unsigned r; asm volatile("v_cvt_pk_bf16_f32 %0, %1, %2" : "=v"(r) : "v"(lo), "v"(hi)); return r; }

template <class Epi, class Sched, bool GATHER, bool ALIGN_EPI>
__device__ __forceinline__ void gemm_phase(LAS unsigned char* lds, const Gemm g, const Sched& S, const Epi& E, const int tid) {
    const int wid = __builtin_amdgcn_readfirstlane(tid >> 6), lane = tid & 63, wr = wid >> 2, wc = wid & 3, fr = lane & 15, fq = lane >> 4;
    const int K = g.K, nt = K / BK, lda = g.lda;
    int sR[2], sC[2]; unsigned voffB[2];
#pragma unroll
    for (int i = 0; i < 2; ++i) { int R, C; stage_rc(tid * 16 + i * 8192, R, C); const int Rb = Epi::PERM ? ((R & ~31) + perm32(R & 31)) : R; sR[i] = R; sC[i] = C; voffB[i] = (unsigned)(Rb * K + C) * 2u; }
    const size_t kstep = (size_t)(BK * 2);
    const size_t hstepB = (size_t)HALF * K * 2;
    const unsigned ldsw = (unsigned)wid * 1024u;
    const int aoff = lds_byte(wr * 64 + fr, fq * 8), boff = lds_byte(wc * 32 + fr, fq * 8);
#define PG8_SA(b, h) (((b) * 2 + (h)) * HTB)
#define PG8_SB(b, h) ((4 + (b) * 2 + (h)) * HTB)
#define PG8_STAGE(bufoff, gbase, v0, v1) do { \
        __builtin_amdgcn_global_load_lds((const unsigned*)((const char*)(gbase) + (v0)), (LAS unsigned*)(lds + (bufoff) + ldsw), 16, 0, 0); \
        __builtin_amdgcn_global_load_lds((const unsigned*)((const char*)(gbase) + (v1)), (LAS unsigned*)(lds + (bufoff) + ldsw + 8192), 16, 0, 0); } while (0)
#define PG8_LDA(dst, b, h) do { _Pragma("unroll") for (int m = 0; m < 4; ++m) _Pragma("unroll") for (int k = 0; k < 2; ++k) dst[m][k] = *(const LAS bf16x8*)(lds + PG8_SA(b, h) + aoff + m * 2048 + k * 1024); } while (0)
#define PG8_LDB(dst, b, h) do { _Pragma("unroll") for (int n = 0; n < 2; ++n) _Pragma("unroll") for (int k = 0; k < 2; ++k) dst[n][k] = *(const LAS bf16x8*)(lds + PG8_SB(b, h) + boff + n * 2048 + k * 1024); } while (0)
#define PG8_MMA(ai, bj, At, Bt) do { __builtin_amdgcn_s_setprio(1); _Pragma("unroll") for (int m = 0; m < 4; ++m) _Pragma("unroll") for (int n = 0; n < 2; ++n) _Pragma("unroll") for (int k = 0; k < 2; ++k) \
        acc[ai][bj][m][n] = __builtin_amdgcn_mfma_f32_16x16x32_bf16(Bt[n][k], At[m][k], acc[ai][bj][m][n], 0, 0, 0); __builtin_amdgcn_s_setprio(0); } while (0)
#define PG8_WAIT_V(n) asm volatile("s_waitcnt vmcnt(" #n ")" ::: "memory")
#define PG8_WAIT_L(n) asm volatile("s_waitcnt lgkmcnt(" #n ")" ::: "memory")
#define PG8_BAR __builtin_amdgcn_s_barrier()
#define PG8_SCHED __builtin_amdgcn_sched_barrier(0)
#define PG8_AOFFS(u, v00, v01, v10, v11) do { int r_[4] = {sR[0], sR[1], 128 + sR[0], 128 + sR[1]}; unsigned o_[4]; _Pragma("unroll") for (int q_ = 0; q_ < 4; ++q_) { int row_; \
        if (GATHER) row_ = (r_[q_] < (u).nvalid) ? ((u).gofs >= 0 ? g.gidx[(u).gofs + r_[q_]] : (u).arow + r_[q_]) : 0; else row_ = (u).arow + r_[q_]; \
        o_[q_] = (unsigned)(row_ * lda + sC[q_ & 1]) * 2u; } v00 = o_[0]; v01 = o_[1]; v10 = o_[2]; v11 = o_[3]; } while (0)
#define PG8_STAGE_A(bufoff, ptr, h) do { if constexpr (GATHER) { if (h) PG8_STAGE(bufoff, ptr, c10, c11); else PG8_STAGE(bufoff, ptr, c00, c01); } \
        else { PG8_STAGE(bufoff, (ptr) + (h) * hstepA, voffA0, voffA1); } } while (0)
    Unit cur, nxt; int ui = 0;
    if (!S.next(0, cur)) return;
    f32x4 acc[2][2][4][2];
    float zf = 0.f; asm volatile("" : "+v"(zf));
#pragma unroll
    for (int a = 0; a < 2; ++a)
#pragma unroll
        for (int b = 0; b < 2; ++b)
#pragma unroll
            for (int m = 0; m < 4; ++m)
#pragma unroll
                for (int n = 0; n < 2; ++n) acc[a][b][m][n] = (f32x4){zf, zf, zf, zf};
    bf16x8 At[4][2], B0[2][2], B1[2][2];
    const size_t hstepA = (size_t)HALF * lda * 2;
    const unsigned voffA0 = (unsigned)(sR[0] * lda + sC[0]) * 2u, voffA1 = (unsigned)(sR[1] * lda + sC[1]) * 2u;
    unsigned c00 = 0, c01 = 0, c10 = 0, c11 = 0, n00 = 0, n01 = 0, n10 = 0, n11 = 0;
    if constexpr (GATHER) { PG8_AOFFS(cur, c00, c01, c10, c11); }
    const char* gA = (const char*)g.A;
    const char* cA = GATHER ? gA : gA + (size_t)cur.arow * lda * 2;
    const char* cB = (const char*)g.Bt + (size_t)cur.brow * K * 2;
    PG8_STAGE(PG8_SB(0, 0), cB, voffB[0], voffB[1]); PG8_STAGE(PG8_SB(0, 1), cB + hstepB, voffB[0], voffB[1]); PG8_STAGE_A(PG8_SA(0, 0), cA, 0); PG8_STAGE_A(PG8_SA(0, 1), cA, 1);
    if (wr == 1) PG8_BAR;
    PG8_WAIT_V(2); PG8_BAR;
    PG8_STAGE(PG8_SB(1, 0), cB + kstep, voffB[0], voffB[1]); PG8_STAGE_A(PG8_SA(1, 0), cA + kstep, 0); PG8_STAGE(PG8_SB(1, 1), cB + hstepB + kstep, voffB[0], voffB[1]);
    PG8_WAIT_V(6); PG8_BAR;
    for (;;) {
        const bool has_next = S.next(ui + 1, nxt);
        if constexpr (GATHER) { if (has_next) { PG8_AOFFS(nxt, n00, n01, n10, n11); } else { n00 = c00; n01 = c01; n10 = c10; n11 = c11; } }
        const char* nA = (GATHER || !has_next) ? cA : gA + (size_t)nxt.arow * lda * 2;
        const char* nB = has_next ? (const char*)g.Bt + (size_t)nxt.brow * K * 2 : cB;
#pragma unroll 1
        for (int t = 0; t < nt; t += 2) {
            const bool last = (t == nt - 2);
            const char* a1 = cA + (size_t)(t + 1) * kstep;
            const char* b2 = last ? nB : cB + (size_t)(t + 2) * kstep;
            const char* b3 = b2 + kstep;
            PG8_LDB(B0, 0, 0); PG8_LDB(B1, 0, 1); PG8_SCHED; PG8_LDA(At, 0, 0); PG8_STAGE_A(PG8_SA(1, 1), a1, 1);
            PG8_WAIT_V(8); PG8_WAIT_L(0); PG8_BAR; PG8_MMA(0, 0, At, B0); PG8_MMA(0, 1, At, B1); PG8_BAR; PG8_SCHED;
            if constexpr (GATHER) { if (last) { c00 = n00; c01 = n01; c10 = n10; c11 = n11; } }
            const char* a2 = last ? nA : cA + (size_t)(t + 2) * kstep;
            const char* a3 = a2 + kstep;
            PG8_LDA(At, 0, 1); PG8_STAGE(PG8_SB(0, 0), b2, voffB[0], voffB[1]); PG8_STAGE(PG8_SB(0, 1), b2 + hstepB, voffB[0], voffB[1]); PG8_STAGE_A(PG8_SA(0, 0), a2, 0);
            PG8_WAIT_V(8); PG8_WAIT_L(0); PG8_BAR; PG8_MMA(1, 0, At, B0); PG8_MMA(1, 1, At, B1); PG8_BAR; PG8_SCHED;
            PG8_LDB(B0, 1, 0); PG8_LDB(B1, 1, 1); PG8_SCHED; PG8_LDA(At, 1, 0); PG8_STAGE_A(PG8_SA(0, 1), a2, 1);
            PG8_WAIT_V(8); PG8_WAIT_L(0); PG8_BAR; PG8_MMA(0, 0, At, B0); PG8_MMA(0, 1, At, B1); PG8_BAR; PG8_SCHED;
            PG8_LDA(At, 1, 1); PG8_STAGE(PG8_SB(1, 0), b3, voffB[0], voffB[1]); PG8_STAGE(PG8_SB(1, 1), b3 + hstepB, voffB[0], voffB[1]); PG8_STAGE_A(PG8_SA(1, 0), a3, 0);
            PG8_WAIT_V(8); PG8_WAIT_L(0); PG8_BAR; PG8_MMA(1, 0, At, B0); PG8_MMA(1, 1, At, B1); PG8_BAR; PG8_SCHED;
        }
        if constexpr (ALIGN_EPI) { if (wr == 0) PG8_BAR; }
        E(acc, cur, wr, wc, fr, fq);
        if (!has_next) break;
#pragma unroll
        for (int a = 0; a < 2; ++a)
#pragma unroll
            for (int b = 0; b < 2; ++b)
#pragma unroll
                for (int m = 0; m < 4; ++m)
#pragma unroll
                    for (int n = 0; n < 2; ++n) acc[a][b][m][n] = (f32x4){zf, zf, zf, zf};
        cur = nxt; cA = nA; cB = nB; ++ui;
        if constexpr (ALIGN_EPI) { if (wr == 1) PG8_BAR; }
    }
    PG8_WAIT_V(0);
    if constexpr (!ALIGN_EPI) { if (wr == 0) PG8_BAR; }
    PG8_BAR;
#undef PG8_STAGE_A
#undef PG8_SA
#undef PG8_SB
#undef PG8_STAGE
#undef PG8_LDA
#undef PG8_LDB
#undef PG8_MMA
#undef PG8_WAIT_V
#undef PG8_WAIT_L
#undef PG8_BAR
#undef PG8_SCHED
#undef PG8_AOFFS
}

struct EpiCols {
    static constexpr bool PERM = true;
    GAS bf16_t* crw; GAS bf16_t* chg;
    __device__ __forceinline__ void operator()(const f32x4 (&acc)[2][2][4][2], const Unit& u, int wr, int wc, int fr, int fq) const {
        GAS bf16_t* base; int ldc, colt;
        if (u.pn < 8) { base = crw; ldc = LD_RW; colt = u.pn * 256; } else { base = chg; ldc = LD_HG; colt = (u.pn - 8) * 256; }
        const int row0 = u.orow + wr * 64 + fr, col0 = colt + wc * 32 + 8 * fq;
#pragma unroll
        for (int ai = 0; ai < 2; ++ai)
#pragma unroll
            for (int m = 0; m < 4; ++m) { GAS bf16_t* rowp = base + (size_t)(row0 + ai * HALF + m * 16) * ldc + col0;
#pragma unroll
                for (int bj = 0; bj < 2; ++bj) { f32x4 v0 = acc[ai][bj][m][0], v1 = acc[ai][bj][m][1];
                    if (u.pn == 6 && bj == 0) {
#pragma unroll
                        for (int e = 0; e < 4; ++e) { v0[e] = ftanh(v0[e]); v1[e] = ftanh(v1[e]); } }
                    u32x4 w; w.x = cvt_pk_bf16(v0[0], v0[1]); w.y = cvt_pk_bf16(v0[2], v0[3]); w.z = cvt_pk_bf16(v1[0], v1[1]); w.w = cvt_pk_bf16(v1[2], v1[3]);
                    *(GAS u32x4*)(rowp + bj * HALF) = w; } }
    }
};
struct EpiFp8 {
    static constexpr bool PERM = true;
    GAS unsigned char* O;
    __device__ __forceinline__ void operator()(const f32x4 (&acc)[2][2][4][2], const Unit& u, int wr, int wc, int fr, int fq) const {
        const int row0 = u.orow + wr * 64 + fr, col0 = u.pn * 256 + wc * 32 + 8 * fq;
#pragma unroll
        for (int ai = 0; ai < 2; ++ai)
#pragma unroll
            for (int m = 0; m < 4; ++m) { GAS unsigned char* rowp = O + (size_t)(row0 + ai * HALF + m * 16) * 1024 + col0;
#pragma unroll
                for (int bj = 0; bj < 2; ++bj) { const f32x4 v0 = acc[ai][bj][m][0], v1 = acc[ai][bj][m][1];
                    int w0 = __builtin_amdgcn_cvt_pk_fp8_f32(v0[0], v0[1], 0, false); w0 = __builtin_amdgcn_cvt_pk_fp8_f32(v0[2], v0[3], w0, true);
                    int w1 = __builtin_amdgcn_cvt_pk_fp8_f32(v1[0], v1[1], 0, false); w1 = __builtin_amdgcn_cvt_pk_fp8_f32(v1[2], v1[3], w1, true);
                    *(GAS u32x2*)(rowp + bj * HALF) = (u32x2){(unsigned)w0, (unsigned)w1}; } }
    }
};
struct EpiSwiglu {
    static constexpr bool PERM = true;
    GAS bf16_t* O;
    __device__ __forceinline__ void operator()(const f32x4 (&acc)[2][2][4][2], const Unit& u, int wr, int wc, int fr, int fq) const {
        const int row0 = u.orow + wr * 64 + fr, col0 = u.pn * 128 + wc * 16 + 4 * fq;
#pragma unroll
        for (int ai = 0; ai < 2; ++ai)
#pragma unroll
            for (int m = 0; m < 4; ++m) { GAS bf16_t* rowp = O + (size_t)(row0 + ai * HALF + m * 16) * 256 + col0;
#pragma unroll
                for (int bj = 0; bj < 2; ++bj) { const f32x4 v0 = acc[ai][bj][m][0], v1 = acc[ai][bj][m][1];
                    const float a0 = fsilu(v0[0]) * v0[1], a1 = fsilu(v0[2]) * v0[3], a2 = fsilu(v1[0]) * v1[1], a3 = fsilu(v1[2]) * v1[3];
                    u32x2 w; w.x = cvt_pk_bf16(a0, a1); w.y = cvt_pk_bf16(a2, a3);
                    *(GAS u32x2*)(rowp + bj * 64) = w; } }
    }
};
struct EpiX1 {
    static constexpr bool PERM = true;
    gcf x; gcf modf; GAS bf16_t* out;
    __device__ __forceinline__ void operator()(const f32x4 (&acc)[2][2][4][2], const Unit& u, int wr, int wc, int fr, int fq) const {
        const int row0 = u.orow + wr * 64 + fr, col0 = u.pn * 256 + wc * 32 + 8 * fq;
        gcf g1 = modf + (size_t)(u.orow >> 11) * NMOD + 2 * DM + col0;
        f32x4 gv[2][2];
#pragma unroll
        for (int bj = 0; bj < 2; ++bj)
#pragma unroll
            for (int n = 0; n < 2; ++n) gv[bj][n] = *(const GAS f32x4*)(g1 + bj * HALF + 4 * n);
#pragma unroll
        for (int ai = 0; ai < 2; ++ai) {
            f32x4 xv[4][2][2];
#pragma unroll
            for (int m = 0; m < 4; ++m) { const size_t off = (size_t)(row0 + ai * HALF + m * 16) * DM + col0;
#pragma unroll
                for (int bj = 0; bj < 2; ++bj) { xv[m][bj][0] = *(const GAS f32x4*)(x + off + bj * HALF); xv[m][bj][1] = *(const GAS f32x4*)(x + off + bj * HALF + 4); } }
            __builtin_amdgcn_sched_barrier(0);
#pragma unroll
            for (int m = 0; m < 4; ++m) { const size_t off = (size_t)(row0 + ai * HALF + m * 16) * DM + col0;
#pragma unroll
                for (int bj = 0; bj < 2; ++bj) {
                    const f32x4 v0 = xv[m][bj][0] + gv[bj][0] * acc[ai][bj][m][0], v1 = xv[m][bj][1] + gv[bj][1] * acc[ai][bj][m][1];
                    u32x4 w; w.x = cvt_pk_bf16(v0[0], v0[1]); w.y = cvt_pk_bf16(v0[2], v0[3]); w.z = cvt_pk_bf16(v1[0], v1[1]); w.w = cvt_pk_bf16(v1[2], v1[3]);
                    *(GAS u32x4*)(out + off + bj * HALF) = w; } }
            __builtin_amdgcn_sched_barrier(0);
        }
    }
};
}

#define XB_TMO      128
#define XB_XCNT(j)  (256  + 64 * (j))
#define XB_XSUB(j)  (1280 + 64 * (j))
#define XB_XGEN(j)  (2304 + 64 * (j))
#define XB_TOP      3328
#define XB_TOPGEN   3392
#define XCD_BAR_WORDS 3456
#define XB_SPIN_CAP (1u << 22)
__device__ __forceinline__ unsigned xb_ld(unsigned* p)              { return __hip_atomic_load(p, __ATOMIC_RELAXED, __HIP_MEMORY_SCOPE_AGENT); }
__device__ __forceinline__ unsigned xb_add(unsigned* p, unsigned v) { return __hip_atomic_fetch_add(p, v, __ATOMIC_RELAXED, __HIP_MEMORY_SCOPE_AGENT); }
__device__ __forceinline__ unsigned xb_xcc_id() { return (unsigned)__builtin_amdgcn_s_getreg((3 << 11) | 20) & 0xFu; }
#define XB_SPIN(cond, bar) do { unsigned _sp = 0; while (cond) { __builtin_amdgcn_s_sleep(1); \
    if ((++_sp & 255u) == 0u) { if (xb_ld(&(bar)[XB_TMO])) break; if (_sp > XB_SPIN_CAP) { atomicAdd(&(bar)[XB_TMO], 1u); break; } } } } while (0)
struct XcdBarrier { unsigned* bar; unsigned x; volatile LAS unsigned* st; };
__device__ __forceinline__ XcdBarrier xcd_barrier_post(unsigned* bar, volatile LAS unsigned* st) {
    XcdBarrier b; b.bar = bar; b.x = xb_xcc_id(); b.st = st;
    if (threadIdx.x == 0) (void)xb_add(&bar[XB_XCNT(b.x)], 1u);
    return b;
}
__device__ __forceinline__ void xcd_barrier_complete(unsigned* bar, unsigned x, unsigned& nloc, unsigned& nx) {
    const unsigned G = gridDim.x * gridDim.y * gridDim.z;
    unsigned sum, cnt, mine, sp = 0u;
    for (;;) {
        sum = 0u; cnt = 0u; mine = 0u;
#pragma unroll 1
        for (unsigned j = 0; j < 16; ++j) { const unsigned c = xb_ld(&bar[XB_XCNT(j)]); sum += c; cnt += (c > 0u) ? 1u : 0u; mine = (j == x) ? c : mine; }
        if (sum == G) break;
        __builtin_amdgcn_s_sleep(1);
        if ((++sp & 255u) == 0u) { if (xb_ld(&bar[XB_TMO])) break; if (sp > XB_SPIN_CAP) { atomicAdd(&bar[XB_TMO], 1u); break; } }
    }
    nloc = mine > 0u ? mine : 1u; nx = cnt > 0u ? cnt : 1u;
}
__device__ __forceinline__ void xcd_barrier(const XcdBarrier& b) {
    asm volatile("s_waitcnt vmcnt(0)" ::: "memory");
    __syncthreads();
    if (threadIdx.x == 0) {
        unsigned* bar = b.bar;
        __builtin_amdgcn_s_waitcnt(0);
        unsigned nloc = b.st[0], nx = b.st[1];
        if (nloc == 0u) { xcd_barrier_complete(bar, b.x, nloc, nx); b.st[0] = nloc; b.st[1] = nx; }
        const unsigned old = xb_add(&bar[XB_XSUB(b.x)], 1u);
        const unsigned gen = old / nloc;
        if (old + 1u == (gen + 1u) * nloc) {
            __builtin_amdgcn_fence(__ATOMIC_RELEASE, "agent");
            asm volatile("s_waitcnt vmcnt(0)" ::: "memory");
            const unsigned og = xb_add(&bar[XB_TOP], 1u);
            const unsigned tg = og / nx;
            if (og + 1u == (tg + 1u) * nx) xb_add(&bar[XB_TOPGEN], 1u);
            else XB_SPIN(xb_ld(&bar[XB_TOPGEN]) == tg, bar);
            __builtin_amdgcn_fence(__ATOMIC_ACQUIRE, "agent");
            xb_add(&bar[XB_XGEN(b.x)], 1u);
            asm volatile("s_waitcnt vmcnt(0)" ::: "memory");
        } else {
            XB_SPIN(xb_ld(&bar[XB_XGEN(b.x)]) == gen, bar);
            __builtin_amdgcn_fence(__ATOMIC_ACQUIRE, "agent");
            asm volatile("s_waitcnt vmcnt(0)" ::: "memory");
        }
    }
    __syncthreads();
}

struct Frame {
    LAS unsigned char* lds;
    volatile LAS unsigned* MISC;
    gu32* ctl;
    int tid, lane, wave, bid, G, dup;
    const gcf __attribute__((address_space(4)))* inp;
    float* out; unsigned char* ws;
};
#define LAUNDER(F) do { asm volatile("" : "+s"((F).ws), "+s"((F).out), "+s"((F).inp)); } while (0)
enum { I_X = 0, I_C, I_CTX, I_CCTX, I_WMOD, I_BMOD, I_N1G, I_N2G, I_WIN, I_CONV, I_W0, I_W2, I_A0, I_A2, I_G2, I_KK, I_KA, I_RK, I_LNG, I_LNB, I_LB, I_HGN, I_WOUT, I_RW, I_RB, I_EG, I_EU, I_ED, I_SG, I_SU, I_SD, I_FNG };

template <bool P2 = false> __device__ __forceinline__ void tr_load(gcf W, int N, int item, int lane, f32x4 (&tv)[8]) {
    const int nblk = N / 32, lnb = __builtin_ctz(nblk), kb = P2 ? item >> lnb : item / nblk, nb = P2 ? item & (nblk - 1) : item % nblk, k0 = 64 * kb, n0 = 32 * nb;
    const GAS float* p = W + (size_t)(k0 + 2 * (lane >> 3)) * N + n0 + 4 * (lane & 7);
#pragma unroll
    for (int i = 0; i < 4; ++i) { tv[2 * i] = *(const GAS f32x4*)(p + (size_t)(16 * i) * N); tv[2 * i + 1] = *(const GAS f32x4*)(p + (size_t)(16 * i + 1) * N); }
}
template <bool P2 = false> __device__ __forceinline__ void tr_finish(const f32x4 (&tv)[8], int K, int N, bf16_t* WT, int row_mul, int row_add, LAS float* scr, int item, int lane) {
    const int nblk = N / 32, lnb = __builtin_ctz(nblk), kb = P2 ? item >> lnb : item / nblk, nb = P2 ? item & (nblk - 1) : item % nblk, k0 = 64 * kb, n0 = 32 * nb;
    LAS unsigned* T = (LAS unsigned*)scr;
    const int kq = lane >> 3, nq = lane & 7;
#pragma unroll
    for (int i = 0; i < 4; ++i)
#pragma unroll
        for (int j = 0; j < 4; ++j) T[(4 * nq + j) * 34 + 8 * i + kq] = cvtpk(tv[2 * i][j], tv[2 * i + 1][j]);
    LDS_WAIT(); asm volatile("" ::: "memory");
    const int c = lane & 7;
#pragma unroll
    for (int j = 0; j < 4; ++j) { const int n = (lane >> 3) + 8 * j; const LAS unsigned* sp = T + n * 34 + 4 * c;
        const u32x2 a = *(const LAS u32x2*)sp, b2 = *(const LAS u32x2*)(sp + 2);
        *(GAS u32x4*)(WT + (size_t)((n0 + n) * row_mul + row_add) * K + k0 + 8 * c) = (u32x4){a.x, a.y, b2.x, b2.y}; }
    LDS_WAIT(); asm volatile("" ::: "memory");
}
__device__ __forceinline__ void p0_transpose_item(gcf W, int K, int N, bf16_t* WT, int row_mul, int row_add, LAS float* scr, int item, int lane) {
    f32x4 tv[8]; tr_load(W, N, item, lane, tv); tr_finish(tv, K, N, WT, row_mul, row_add, scr, item, lane);
}
constexpr int NEXP_ITEMS = 65 * 384;
struct ExpItem { gcf W; bf16_t* WT; int K, N, row_mul, row_add, sub; };
__device__ __forceinline__ ExpItem exp_item(Frame& F, int idx) {
    const int e = idx / 384, q = idx % 384, which = q >> 7, sub = q & 127;
    bf16_t* W1E = (bf16_t*)(F.ws + WS_W1E); bf16_t* W2E = (bf16_t*)(F.ws + WS_W2E);
    gcf pEG = F.inp[I_EG], pEU = F.inp[I_EU], pED = F.inp[I_ED], pSG = F.inp[I_SG], pSU = F.inp[I_SU], pSD = F.inp[I_SD];
    asm volatile("" : "+s"(pEG), "+s"(pEU), "+s"(pED), "+s"(pSG), "+s"(pSU), "+s"(pSD));
    ExpItem it;
    if (which == 0) { it.W = e < 64 ? pEG + (size_t)e * DM * 256 : pSG; it.WT = W1E + (size_t)e * 512 * DM; it.K = DM; it.N = 256; it.row_mul = 2; it.row_add = 0; }
    else if (which == 1) { it.W = e < 64 ? pEU + (size_t)e * DM * 256 : pSU; it.WT = W1E + (size_t)e * 512 * DM; it.K = DM; it.N = 256; it.row_mul = 2; it.row_add = 1; }
    else { it.W = e < 64 ? pED + (size_t)e * 256 * DM : pSD; it.WT = W2E + (size_t)e * DM * 256; it.K = 256; it.N = DM; it.row_mul = 1; it.row_add = 0; }
    it.sub = sub; return it;
}
__device__ __forceinline__ void p0a(Frame& F) {
    LAUNDER(F);
    LAS float* scr = (LAS float*)(F.lds + F.wave * 16384);
    const int gw = F.bid * 8 + F.wave, NGW = F.G * 8;
    unsigned char* ws = F.ws;
    bf16_t* WIN = (bf16_t*)(ws + WS_WIN); bf16_t* WOUT = (bf16_t*)(ws + WS_WOUT); bf16_t* G2T = (bf16_t*)(ws + WS_G2T);
    constexpr int I_IN = 16 * 140, I_OUT = 16 * 32, I_G2T = 2 * 16;
    constexpr int NITEMS = I_IN + I_OUT + I_G2T;
    for (int it = gw; it < NITEMS; it += NGW) {
        int r = it;
        if (r < I_IN) { const int nb = r % 140; p0_transpose_item(F.inp[I_WIN], DM, P_IN, WIN, 1, (nb * 32 >= 1920) ? 128 : 0, scr, r, F.lane); continue; } r -= I_IN;
        if (r < I_OUT) { p0_transpose_item(F.inp[I_WOUT], DM, DM, WOUT, 1, 0, scr, r, F.lane); continue; } r -= I_OUT;
        p0_transpose_item(F.inp[I_G2], 128, 512, G2T, 1, 0, scr, r, F.lane);
    }
    { const int gt = F.bid * 512 + F.tid; unsigned zu = 0u; asm volatile("" : "+v"(zu)); if (gt < 128 * 1024 / 8) *(GAS u32x4*)(WIN + (size_t)1920 * DM + (size_t)gt * 8) = (u32x4){zu, zu, zu, zu}; }
    { bf16_t* RWT = (bf16_t*)(ws + WS_RWT); const int gt = F.bid * 512 + F.tid; if (gt < 65536) { const int e = gt >> 10, col = gt & 1023; const float w = F.inp[I_RW][col * 64 + e]; const unsigned short hi = cvt1(w); RWT[gt] = hi; RWT[65536 + gt] = cvt1(w - bf2f(hi)); } }
    float* MODP = (float*)(ws + WS_MODP);
    for (int q = gw; q < 96 * 16; q += NGW) {
        const int cg = q % 96, ks = q / 96, col = cg * 64 + F.lane, k0 = ks * 64;
        float sv[17], acc[17];
#pragma unroll
        for (int b = 0; b < 17; ++b) { const float cv = (b < 16) ? F.inp[I_C][b * DM + k0 + F.lane] : F.inp[I_CCTX][k0 + F.lane]; sv[b] = siluf_(cv); acc[b] = 0.f; }
        gcf wp = F.inp[I_WMOD] + (size_t)k0 * NMOD + col;
#pragma unroll 8
        for (int kk = 0; kk < 64; ++kk) { const float w = wp[(size_t)kk * NMOD];
#pragma unroll
            for (int b = 0; b < 17; ++b) acc[b] += __builtin_bit_cast(float, __builtin_amdgcn_readlane(__builtin_bit_cast(int, sv[b]), kk)) * w; }
#pragma unroll
        for (int b = 0; b < 17; ++b) MODP[(size_t)(ks * 17 + b) * NMOD + col] = acc[b];
    }
}
__device__ __forceinline__ float mod_val(Frame& F, int b, int j) {
    const float* MODP = (const float*)(F.ws + WS_MODP);
    float s = F.inp[I_BMOD][j];
#pragma unroll
    for (int ks = 0; ks < 16; ++ks) s += MODP[(size_t)(ks * 17 + b) * NMOD + j];
    return s;
}
__device__ __forceinline__ void h_rows(Frame& F, gcf src, bf16_t* dst, int nrows, LAS float* gs, LAS float* sh) {
    for (int r = F.wave; r < nrows; r += 8) {
        const GAS f32x4* xr = (const GAS f32x4*)(src + (size_t)r * DM) + F.lane;
        f32x4 v[4]; float s = 0.f;
#pragma unroll
        for (int j = 0; j < 4; ++j) { v[j] = xr[64 * j]; s += (v[j].x * v[j].x + v[j].y * v[j].y) + (v[j].z * v[j].z + v[j].w * v[j].w); }
        const float rstd = 1.0f / sqrtf(wave_sum(s) * (1.f / DM) + 1e-6f);
        GAS u32x2* o8 = (GAS u32x2*)(dst + (size_t)r * DM) + F.lane;
#pragma unroll
        for (int j = 0; j < 4; ++j) { const int c = 4 * F.lane + 256 * j; const f32x4 g = *(const LAS f32x4*)(gs + c), h = *(const LAS f32x4*)(sh + c);
            u32x2 w; w.x = pk2(v[j].x * rstd * g.x + h.x, v[j].y * rstd * g.y + h.y); w.y = pk2(v[j].z * rstd * g.z + h.z, v[j].w * rstd * g.w + h.w); o8[64 * j] = w; }
    }
}
__device__ __forceinline__ void p0b(Frame& F) {
    LAUNDER(F);
    float* MODF = (float*)(F.ws + WS_MODF);
    { const int gt = F.bid * 512 + F.tid; if (gt < 17 * NMOD) MODF[gt] = mod_val(F, gt / NMOD, gt % NMOD); }
    LAS float* gs = (LAS float*)F.lds; LAS float* sh = gs + DM;
    bf16_t* H = (bf16_t*)F.out;
    const int b = F.bid >> 4;
    for (int pass = 0; pass < 2; ++pass) {
        const int mb = pass == 0 ? b : 16;
        __syncthreads();
        for (int c = F.tid; c < DM; c += 512) { gs[c] = F.inp[I_N1G][c] * (1.0f + mod_val(F, mb, DM + c)); sh[c] = mod_val(F, mb, c); }
        __syncthreads();
        if (pass == 0) { const int r0 = b * SEQ + (F.bid & 15) * 128; h_rows(F, F.inp[I_X] + (size_t)r0 * DM, H + (size_t)r0 * DM, 128, gs, sh); }
        else { const int r0 = F.bid * 16; h_rows(F, F.inp[I_CTX] + (size_t)r0 * DM, H + (size_t)(NT + r0) * DM, 16, gs, sh); }
    }
}

__device__ __forceinline__ int conv_nb(int seg, int t, int dy, int dx) {
    if (seg == 1) { const int yy = (t >> 6) + dy, xx = (t & 63) + dx; const bool ok = (yy >= 0) && (yy < 32) && (xx >= 0) && (xx < 64); return ok ? yy * 64 + xx : -1; }
    const int tt = t + dx; const bool ok = (dy == 0) && (tt >= 0) && (tt < CTXL); return ok ? tt : -1;
}
__device__ __forceinline__ void rwkv_unit(Frame& F, int b, int h, int d) {
    LAUNDER(F);
    int tle = F.tid; asm volatile("" : "+v"(tle));
    const int tid = tle, wave = F.wave;
#define RW_PTRS() unsigned char* wsl_ = F.ws; float* outl_ = F.out; asm volatile("" : "+s"(wsl_), "+s"(outl_)); \
    const GAS bf16_t* CRW = (const GAS bf16_t*)(wsl_ + WS_CRW); GAS bf16_t* YRW = (GAS bf16_t*)outl_ + (size_t)d * NT * 512; GAS bf16_t* VCONV = (GAS bf16_t*)(wsl_ + WS_VCONV); \
    GAS float* CSC = (GAS float*)(wsl_ + WS_CSC) + (size_t)d * NT * 8; const GAS unsigned char* WSB = (const GAS unsigned char*)wsl_; (void)CRW; (void)YRW; (void)VCONV; (void)CSC; (void)WSB
    constexpr unsigned ZOFF = (unsigned)WS_WIN + 1920u * DM * 2u;
    LAS float* L = (LAS float*)F.lds;
    LAS float* RC = L;
    LAS float* KT = L + 2048;
    LAS float* VC = L + 4096;
    LAS float* PW = L + 6144;
    LAS float* PA = L + 8192;
    LAS float* LY = L + 10240;
    LAS float* CW = L + 12288;
    LAS float* GT = L + 14080;
    LAS float* LGK = L + 14592;
    LAS float* PAR = L + 14656;
    LAS float* INVN = L + 14976;
    LAS float* R16 = L + 15008;
    LAS float* CSV = (LAS float*)(F.lds + 132096);
    LAS bf16_t* AH = (LAS bf16_t*)(F.lds + 61440);
    LAS bf16_t* BC = AH + 32 * 72;
    LAS bf16_t* KC = BC + 32 * 72;
    LAS bf16_t* RH = KC + 32 * 72;
    LAS bf16_t* A0 = RH + 32 * 72;
    LAS bf16_t* R0 = A0 + 32 * 72;
    LAS bf16_t* BBT = R0 + 32 * 72;
    LAS bf16_t* KBT = BBT + 64 * 40;
    LAS bf16_t* VT = KBT + 64 * 40;
    LAS bf16_t* SAT = VT + 64 * 40;
    LAS bf16_t* NLb = SAT + 64 * 40;
    for (int i = tid; i < 4096; i += 512) { const int j = i >> 6, c = i & 63; L[i] = F.inp[I_W2][(size_t)(d * 64 + j) * 512 + h * 64 + c]; L[4096 + i] = F.inp[I_A2][(size_t)(d * 64 + j) * 512 + h * 64 + c]; }
    LDS_BARRIER();
    bf16x8 bfrag[4];
    if (wave >= 2 && wave < 6) {
        const int arr = (wave - 2) >> 1, ct = (wave - 2) & 1, hh = (tid & 63) >> 5;
        const LAS float* Ws = L + arr * 4096 + ct * 32 + (tid & 31);
#pragma unroll
        for (int js = 0; js < 4; ++js) { u32x4 t;
            t.x = cvtpk(Ws[(16 * js + 8 * hh + 0) * 64], Ws[(16 * js + 8 * hh + 1) * 64]); t.y = cvtpk(Ws[(16 * js + 8 * hh + 2) * 64], Ws[(16 * js + 8 * hh + 3) * 64]);
            t.z = cvtpk(Ws[(16 * js + 8 * hh + 4) * 64], Ws[(16 * js + 8 * hh + 5) * 64]); t.w = cvtpk(Ws[(16 * js + 8 * hh + 6) * 64], Ws[(16 * js + 8 * hh + 7) * 64]);
            bfrag[js] = __builtin_bit_cast(bf16x8, t); }
    }
    LDS_BARRIER();
    for (int i = tid; i < 9 * 192; i += 512) { const int tap = i / 192, q = i % 192, which = q >> 6, c = q & 63; CW[i] = F.inp[I_CONV][tap * 1536 + which * 512 + h * 64 + c]; }
    if (tid < 64) { const int chp = h * 64 + tid;
        PAR[tid] = F.inp[I_KK][chp]; PAR[64 + tid] = F.inp[I_KA][chp]; PAR[128 + tid] = F.inp[I_RK][chp]; PAR[192 + tid] = F.inp[I_W0][d * 512 + chp]; PAR[256 + tid] = F.inp[I_A0][d * 512 + chp]; }
    LAS unsigned* MSK = (LAS unsigned*)(F.lds + 140288);
    if (tid < 192) { const int ty = tid >> 6, ln = tid & 63, r32_ = ln & 31, hh_ = ln >> 5;
#pragma unroll
        for (int m = 0; m < 8; ++m) { const int i0 = 2 * m, cr0 = (i0 & 3) + 8 * (i0 >> 2) + 4 * hh_, cr1 = cr0 + 1;
            const bool k0 = ty == 0 ? (r32_ < cr0) : (ty == 1 ? (cr0 < r32_) : (cr0 <= r32_)), k1 = ty == 0 ? (r32_ < cr1) : (ty == 1 ? (cr1 < r32_) : (cr1 <= r32_));
            MSK[(ty * 64 + ln) * 8 + m] = (k0 ? 0xffffu : 0u) | (k1 ? 0xffff0000u : 0u); } }
    LAS f32x4* SST = (LAS f32x4*)(F.lds + 114688) + wave * 512 + (tid & 63);
    if (wave < 2) {
#pragma unroll
        for (int q = 0; q < 8; ++q) SST[q * 64] = (f32x4){0.f, 0.f, 0.f, 0.f};
    }
    u32x4 tp0[9], tp1[9], lraw[4];
    const bool nostore = F.dup && DUP_MODE >= 5;
    const bool sk_mfma = F.dup && DUP_MODE == 5, sk_conv = F.dup && DUP_MODE == 6, sk_p2 = F.dup && DUP_MODE == 7, sk_p1 = F.dup && DUP_MODE == 8;
#define RW_GEOM(cgi, seg, Ls, rowbase, t0) const int seg = (cgi) < 8 ? 0 : 1, Ls = seg == 0 ? CTXL : SEQ, rowbase = seg == 0 ? NT + b * CTXL : b * SEQ, \
        t0 = d == 0 ? ((cgi) - (seg ? 8 : 0)) * TCS : Ls - 1 - ((cgi) - (seg ? 8 : 0)) * TCS
#define RW_TAPS(tp, cgi, item_) do { RW_GEOM(cgi, seg_, Ls_, rb_, t0_); (void)Ls_; const int dir_ = d == 0 ? 1 : -1; \
        const int cs_ = (item_) / 24, cg_ = (item_) % 24, t = t0_ + dir_ * cs_; const int colb = (cg_ >> 3) * 512 + h * 64 + (cg_ & 7) * 8; \
        const int y_ = t >> 6, x_ = seg_ ? (t & 63) : t, xmax_ = seg_ ? 63 : CTXL - 1; \
        const bool ym_ = seg_ && y_ > 0, yp_ = seg_ && y_ < 31, xm_ = x_ > 0, xp_ = x_ < xmax_; \
        const unsigned boff_ = (unsigned)WS_CRW + (unsigned)((rb_ + t) * LD_RW + colb) * 2u, zoff_ = ZOFF + (unsigned)colb * 2u; \
        _Pragma("unroll") for (int q = 0; q < 9; ++q) { const int dy = q / 3 - 1, dx = q % 3 - 1; \
            const bool ok = (dy == 0 || (dy < 0 ? ym_ : yp_)) && (dx == 0 || (dx < 0 ? xm_ : xp_)); \
            const unsigned off_ = ok ? boff_ + (unsigned)((dy * 64 + dx) * LD_RW * 2) : zoff_; tp[q] = *(const GAS u32x4*)(WSB + off_); } } while (0)
#define RW_TAPGEO(cgi, item_, boff_, zoff_, ym_, yp_, xm_, xp_) do { RW_GEOM(cgi, seg_, Ls_, rb_, t0_); (void)Ls_; const int dir_ = d == 0 ? 1 : -1; \
        const int cs_ = (item_) / 24, cg_ = (item_) % 24, t = t0_ + dir_ * cs_; const int colb = (cg_ >> 3) * 512 + h * 64 + (cg_ & 7) * 8; \
        const int y_ = t >> 6, x_ = seg_ ? (t & 63) : t, xmax_ = seg_ ? 63 : CTXL - 1; \
        ym_ = seg_ && y_ > 0; yp_ = seg_ && y_ < 31; xm_ = x_ > 0; xp_ = x_ < xmax_; \
        boff_ = (unsigned)WS_CRW + (unsigned)((rb_ + t) * LD_RW + colb) * 2u; zoff_ = ZOFF + (unsigned)colb * 2u; } while (0)
#define RW_TAPQ(tp, q, boff_, zoff_, ym_, yp_, xm_, xp_) do { constexpr int dy = (q) / 3 - 1, dx = (q) % 3 - 1; \
        const bool ok = (dy == 0 || (dy < 0 ? ym_ : yp_)) && (dx == 0 || (dx < 0 ? xm_ : xp_)); \
        const unsigned off_ = ok ? boff_ + (unsigned)((dy * 64 + dx) * LD_RW * 2) : zoff_; tp[q] = *(const GAS u32x4*)(WSB + off_); } while (0)
#define RW_LRAW(cgi, tq_) do { if (wave < 6) { RW_GEOM(cgi, seg_, Ls_, rb_, t0_); (void)Ls_; (void)seg_; const int dir_ = d == 0 ? 1 : -1; const int t = t0_ + dir_ * ((tq_) & 31); const GAS bf16_t* rp = CRW + (size_t)(rb_ + t) * LD_RW + (((wave - 2) >> 1) == 0 ? 1536 : 1664) + d * 64 + 8 * (((tq_) & 63) >> 5); \
          _Pragma("unroll") for (int js = 0; js < 4; ++js) lraw[js] = *(const GAS u32x4*)(rp + 16 * js); } } while (0)
#define RW_LOAD0(cgi, tq_) do { RW_TAPS(tp0, cgi, (tq_)); \
        if (wave < 6) { RW_GEOM(cgi, seg_, Ls_, rb_, t0_); (void)Ls_; (void)seg_; const int dir_ = d == 0 ? 1 : -1; const int t = t0_ + dir_ * ((tq_) & 31); const GAS bf16_t* rp = CRW + (size_t)(rb_ + t) * LD_RW + (((wave - 2) >> 1) == 0 ? 1536 : 1664) + d * 64 + 8 * (((tq_) & 63) >> 5); \
          _Pragma("unroll") for (int js = 0; js < 4; ++js) lraw[js] = *(const GAS u32x4*)(rp + 16 * js); } } while (0)
#define RW_LOAD1(cgi, tq_) RW_TAPS(tp1, cgi, (tq_) + 384)
#define RW_CONV_EPI(o, cs_, cgn2_) do { LAS float* dst = (which == 0 ? RC : (which == 1 ? KT : VC)) + (cs_) * 64 + c0; \
        *(LAS f32x4*)dst = (f32x4){o[0], o[1], o[2], o[3]}; *(LAS f32x4*)(dst + 4) = (f32x4){o[4], o[5], o[6], o[7]}; \
        if (d == 0 && which == 2) { RW_GEOM(cgn2_, sg_, Lg_, rg_, tg_); (void)Lg_;     \
            if (sg_ == 1) *(GAS u32x4*)(VCONV + (size_t)(rg_ + tg_ + (cs_)) * 512 + h * 64 + c0) = (u32x4){cvtpk(o[0], o[1]), cvtpk(o[2], o[3]), cvtpk(o[4], o[5]), cvtpk(o[6], o[7])}; } \
        { float ss_ = (o[0] * k0_.x) * (o[0] * k0_.x) + (o[1] * k0_.y) * (o[1] * k0_.y) + (o[2] * k0_.z) * (o[2] * k0_.z) + (o[3] * k0_.w) * (o[3] * k0_.w) \
                    + (o[4] * k1_.x) * (o[4] * k1_.x) + (o[5] * k1_.y) * (o[5] * k1_.y) + (o[6] * k1_.z) * (o[6] * k1_.z) + (o[7] * k1_.w) * (o[7] * k1_.w);     \
          ss_ = oct_sum(ss_); if (cgq_ == 8) INVN[(cs_)] = __builtin_amdgcn_rsqf(fmaxf(ss_, 1e-24f)); } } while (0)
#define RW_CONV2(it_, cgn2_) do { const int csa_ = (it_) / 24, cgq_ = (it_) % 24, which = cgq_ >> 3, c0 = (cgq_ & 7) * 8; float oa[8], ob[8]; \
        _Pragma("unroll") for (int e = 0; e < 8; ++e) { oa[e] = 0.f; ob[e] = 0.f; } \
        _Pragma("unroll") for (int q = 0; q < 9; ++q) { \
            const LAS float* cw = CW + q * 192 + which * 64 + c0; const f32x4 w0 = *(const LAS f32x4*)cw, w1 = *(const LAS f32x4*)(cw + 4); const u32x4 ra = tp0[q], rb2 = tp1[q]; \
            oa[0] += bflo(ra.x) * w0.x; oa[1] += bfhi(ra.x) * w0.y; oa[2] += bflo(ra.y) * w0.z; oa[3] += bfhi(ra.y) * w0.w; \
            oa[4] += bflo(ra.z) * w1.x; oa[5] += bfhi(ra.z) * w1.y; oa[6] += bflo(ra.w) * w1.z; oa[7] += bfhi(ra.w) * w1.w; \
            ob[0] += bflo(rb2.x) * w0.x; ob[1] += bfhi(rb2.x) * w0.y; ob[2] += bflo(rb2.y) * w0.z; ob[3] += bfhi(rb2.y) * w0.w; \
            ob[4] += bflo(rb2.z) * w1.x; ob[5] += bfhi(rb2.z) * w1.y; ob[6] += bflo(rb2.w) * w1.z; ob[7] += bfhi(rb2.w) * w1.w; \
            if (q % 3 == 2) asm volatile("" ::: "memory"); } \
        const f32x4 k0_ = *(const LAS f32x4*)(PAR + c0), k1_ = *(const LAS f32x4*)(PAR + c0 + 4); \
        RW_CONV_EPI(oa, csa_, cgn2_); RW_CONV_EPI(ob, csa_ + 16, cgn2_); } while (0)
#define RW_PREA(cgn_, tq_) do { RW_LOAD1(cgn_, tq_); \
        if (wave < 6) { const int arr = (wave - 2) >> 1, ct = (wave - 2) & 1, hh = ((tq_) & 63) >> 5; f32x16 acc; \
            _Pragma("unroll") for (int i = 0; i < 16; ++i) acc[i] = 0.f; \
            _Pragma("unroll") for (int js = 0; js < 4; ++js) { u32x4 raw = lraw[js]; \
                acc = __builtin_amdgcn_mfma_f32_32x32x16_bf16(__builtin_bit_cast(bf16x8, raw), bfrag[js], acc, 0, 0, 0); } \
            LAS float* dstp = (arr == 0 ? PW : PA) + ct * 32 + ((tq_) & 31); \
            _Pragma("unroll") for (int i = 0; i < 16; ++i) { const int srow = (i & 3) + 8 * (i >> 2) + 4 * hh; dstp[srow * 64] = acc[i]; } } \
        RW_CONV2((tq_), cgn_); } while (0)
    LDS_BARRIER();
    if (wave >= 2) { RW_PTRS(); const int tq = tid - 128; RW_LOAD0(0, tq); RW_PREA(0, tq); RW_TAPS(tp0, 1, tq); RW_LRAW(1, tq); }
    LDS_BARRIER();
#pragma unroll 1
    for (int cgi = 0; cgi < 72; ++cgi) {
        RW_GEOM(cgi, seg, Ls, rowbase, t0); (void)Ls;
        const int dir = d == 0 ? 1 : -1;
        int tl = tid; asm volatile("" : "+v"(tl));
        RW_PTRS();
        const int lane = tl & 63, k = lane, g4 = 4 * wave, ch = h * 64 + lane;
        float va[4], vb[4], vk[4], vr[4], vv[4], vlw[4];
        const float p_w0 = PAR[192 + lane];
        {
            const float p_kk = PAR[lane], p_ka = PAR[64 + lane], p_a0 = PAR[256 + lane], p_rk = PAR[128 + lane];
            float csv[4];
#pragma unroll
            for (int t = 0; t < 4; ++t) {
                const int p = g4 + t, idx = p * 64 + lane, tok = t0 + dir * p;
                const float kc = KT[idx], r = RC[idx], v = VC[idx], af = fsigmoid(PA[idx] + p_a0), sw = fsigmoid(PW[idx] + p_w0);
                const float kk = kc * p_kk * INVN[p];
                const float kd = kc * (1.0f + (af - 1.0f) * p_ka);
                va[t] = -kk; vb[t] = kk * af; vk[t] = kd; vr[t] = r; vv[t] = v; vlw[t] = -0.87503870f * sw;
                csv[t] = r * kd * p_rk;
            }
            if (seg == 1) {
#pragma unroll
                for (int t = 0; t < 4; ++t) CSV[(g4 + t) * 64 + lane] = csv[t];
            }
        }
        const float c0 = vlw[0], c1 = c0 + vlw[1], c2 = c1 + vlw[2], c3 = c2 + vlw[3];
        GT[wave * 64 + k] = c3;
        if (wave == 4) R16[k] = vlw[0];
        if (cgi > 8 && !nostore) {
            RW_GEOM(cgi - 1, segp, Lsp, rbp, t0p); (void)Lsp; (void)segp;
            const int s_ = tl >> 4, v0 = 4 * (tl & 15), t = t0p + dir * s_;
            const f32x4 yv = *(const LAS f32x4*)(LY + s_ * 64 + v0);
            u32x2 w; w.x = cvtpk(yv.x, yv.y); w.y = cvtpk(yv.z, yv.w);
            *(GAS u32x2*)(YRW + (size_t)(rbp + t) * 512 + h * 64 + v0) = w;
        }
        LDS_BARRIER();
        if (!sk_p2) {
            float pre = 0.f, last = 0.f, rho = 0.f;
#pragma unroll
            for (int gg = 0; gg < 8; ++gg) { const float gt = GT[gg * 64 + k]; const unsigned mk_ = gg < wave ? 0xffffffffu : 0u;
                pre += __builtin_bit_cast(float, __builtin_bit_cast(unsigned, gt) & mk_); if (gg < 4) rho += gt; last += gt; }
            rho += R16[k];
            const float er = __builtin_amdgcn_exp2f(rho), eir = __builtin_amdgcn_exp2f(-rho), el = __builtin_amdgcn_exp2f(last);
            const float cum[4] = {pre + c0, pre + c1, pre + c2, pre + c3};
            float bbf[4], kbf[4];
            float ecp = __builtin_amdgcn_exp2f(pre);
#pragma unroll
            for (int t = 0; t < 4; ++t) {
                const int p = g4 + t;
                const float ec = __builtin_amdgcn_exp2f(cum[t]), eic = __builtin_amdgcn_exp2f(-cum[t]), ecx = ecp; ecp = ec;
                AH[p * 72 + k] = cvt1(va[t] * ecx * eir); BC[p * 72 + k] = cvt1(vb[t] * er * eic); KC[p * 72 + k] = cvt1(vk[t] * er * eic); RH[p * 72 + k] = cvt1(vr[t] * ec * eir);
                A0[p * 72 + k] = cvt1(va[t] * ecx); R0[p * 72 + k] = cvt1(vr[t] * ec);
                bbf[t] = vb[t] * el * eic; kbf[t] = vk[t] * el * eic;
            }
            *(LAS u32x2*)(BBT + k * 40 + g4) = (u32x2){cvtpk(bbf[0], bbf[1]), cvtpk(bbf[2], bbf[3])};
            *(LAS u32x2*)(KBT + k * 40 + g4) = (u32x2){cvtpk(kbf[0], kbf[1]), cvtpk(kbf[2], kbf[3])};
            *(LAS u32x2*)(VT + k * 40 + g4) = (u32x2){cvtpk(vv[0], vv[1]), cvtpk(vv[2], vv[3])};
            if (wave == 0) LGK[k] = el;
        }
        LDS_BARRIER();
        if (wave < 2 && !sk_mfma) {
            const int vt = wave, r32 = lane & 31, hh = lane >> 5;
            (void)NLb;
            f32x16 S0, S1;
#pragma unroll
            for (int q = 0; q < 4; ++q) { const f32x4 x0 = SST[q * 64], x1 = SST[(4 + q) * 64];
#pragma unroll
                for (int e = 0; e < 4; ++e) { S0[4 * q + e] = x0[e]; S1[4 * q + e] = x1[e]; } }
#define RWC_ROWFRAG(arr, row, s_) (*(const LAS bf16x8*)((arr) + (row) * 72 + 16 * (s_) + 8 * hh))
#define RWC_PACK(dst, T, s_) do { u32x4 p_; p_.x = cvtpk((T)[8 * (s_) + 0], (T)[8 * (s_) + 1]); p_.y = cvtpk((T)[8 * (s_) + 2], (T)[8 * (s_) + 3]); p_.z = cvtpk((T)[8 * (s_) + 4], (T)[8 * (s_) + 5]); p_.w = cvtpk((T)[8 * (s_) + 6], (T)[8 * (s_) + 7]); dst = __builtin_bit_cast(bf16x8, p_); } while (0)
#define RWC_PACKM(dst, T, s_, M0, M1) do { u32x4 p_; const u32x4 mm_ = (s_) == 0 ? (M0) : (M1); p_.x = cvtpk((T)[8 * (s_) + 0], (T)[8 * (s_) + 1]) & mm_.x; p_.y = cvtpk((T)[8 * (s_) + 2], (T)[8 * (s_) + 3]) & mm_.y; p_.z = cvtpk((T)[8 * (s_) + 4], (T)[8 * (s_) + 5]) & mm_.z; p_.w = cvtpk((T)[8 * (s_) + 6], (T)[8 * (s_) + 7]) & mm_.w; dst = __builtin_bit_cast(bf16x8, p_); } while (0)
#define RWC_PERM(dst, ptr) do { const u32x2 q0_ = *(const LAS u32x2*)(ptr), q1_ = *(const LAS u32x2*)((ptr) + 8); const u32x4 q_ = {q0_.x, q0_.y, q1_.x, q1_.y}; dst = __builtin_bit_cast(bf16x8, q_); } while (0)
            f32x16 Nm, Nt, X2, Wm;
#pragma unroll
            for (int i = 0; i < 16; ++i) { Nm[i] = 0.f; Nt[i] = 0.f; X2[i] = 0.f; Wm[i] = 0.f; }
#pragma unroll
            for (int s_ = 0; s_ < 4; ++s_) {
                const bf16x8 fa = RWC_ROWFRAG(AH, r32, s_), fb = RWC_ROWFRAG(BC, r32, s_), fk = RWC_ROWFRAG(KC, r32, s_);
                Nm = __builtin_amdgcn_mfma_f32_32x32x16_bf16(fa, fb, Nm, 0, 0, 0);
                Nt = __builtin_amdgcn_mfma_f32_32x32x16_bf16(fb, fa, Nt, 0, 0, 0);
                X2 = __builtin_amdgcn_mfma_f32_32x32x16_bf16(fk, fa, X2, 0, 0, 0);
            }
            const LAS u32x4* mkp = (const LAS u32x4*)(MSK + lane * 8);
            const u32x4 mN0 = mkp[0], mN1 = mkp[1], mT0 = mkp[128], mT1 = mkp[129];
            __builtin_amdgcn_sched_barrier(0);
#pragma unroll
            for (int kb = 0; kb < 2; ++kb)
#pragma unroll
                for (int s_ = 0; s_ < 2; ++s_) { bf16x8 fa, fs; RWC_PERM(fa, A0 + r32 * 72 + kb * 32 + 16 * s_ + 4 * hh); if (kb == 0) RWC_PACK(fs, S0, s_); else RWC_PACK(fs, S1, s_);
                    Wm = __builtin_amdgcn_mfma_f32_32x32x16_bf16(fa, fs, Wm, 0, 0, 0); }
#pragma unroll
            for (int s_ = 0; s_ < 2; ++s_) { bf16x8 fx, fv; RWC_PACKM(fx, X2, s_, mT0, mT1); RWC_PERM(fv, VT + (vt * 32 + r32) * 40 + 16 * s_ + 4 * hh);
                Wm = __builtin_amdgcn_mfma_f32_32x32x16_bf16(fx, fv, Wm, 0, 0, 0); }
            __builtin_amdgcn_sched_barrier(0);
#pragma unroll
            for (int lvl = 0; lvl < 5; ++lvl) {
                bf16x8 q0, q1, w0, w1; if (lvl == 0) { RWC_PACKM(q0, Nt, 0, mT0, mT1); RWC_PACKM(q1, Nt, 1, mT0, mT1); } else { RWC_PACK(q0, Nt, 0); RWC_PACK(q1, Nt, 1); } RWC_PACK(w0, Wm, 0); RWC_PACK(w1, Wm, 1);
                Wm = __builtin_amdgcn_mfma_f32_32x32x16_bf16(q0, w0, Wm, 0, 0, 0);
                Wm = __builtin_amdgcn_mfma_f32_32x32x16_bf16(q1, w1, Wm, 0, 0, 0);
                if (lvl < 4) {
                    bf16x8 p0, p1; if (lvl == 0) { RWC_PACKM(p0, Nm, 0, mN0, mN1); RWC_PACKM(p1, Nm, 1, mN0, mN1); } else { RWC_PACK(p0, Nm, 0); RWC_PACK(p1, Nm, 1); }
                    f32x16 P2, Q2;
#pragma unroll
                    for (int i = 0; i < 16; ++i) { P2[i] = 0.f; Q2[i] = 0.f; }
                    P2 = __builtin_amdgcn_mfma_f32_32x32x16_bf16(q0, p0, P2, 0, 0, 0);
                    Q2 = __builtin_amdgcn_mfma_f32_32x32x16_bf16(p0, q0, Q2, 0, 0, 0);
                    P2 = __builtin_amdgcn_mfma_f32_32x32x16_bf16(q1, p1, P2, 0, 0, 0);
                    Q2 = __builtin_amdgcn_mfma_f32_32x32x16_bf16(p1, q1, Q2, 0, 0, 0);
                    Nm = P2; Nt = Q2;
                }
                __builtin_amdgcn_sched_barrier(0);
            }
#pragma unroll
            for (int q4 = 0; q4 < 4; ++q4) *(LAS u32x2*)(SAT + (vt * 32 + r32) * 40 + 8 * q4 + 4 * hh) = (u32x2){cvtpk(Wm[4 * q4 + 0], Wm[4 * q4 + 1]), cvtpk(Wm[4 * q4 + 2], Wm[4 * q4 + 3])};
            __builtin_amdgcn_sched_barrier(0);
            if (seg == 1) {
                f32x16 X3, X4, Ym;
#pragma unroll
                for (int i = 0; i < 16; ++i) { X3[i] = 0.f; X4[i] = 0.f; Ym[i] = 0.f; }
#pragma unroll
                for (int s_ = 0; s_ < 4; ++s_) {
                    const bf16x8 fr = RWC_ROWFRAG(RH, r32, s_), fb = RWC_ROWFRAG(BC, r32, s_), fk = RWC_ROWFRAG(KC, r32, s_);
                    X3 = __builtin_amdgcn_mfma_f32_32x32x16_bf16(fb, fr, X3, 0, 0, 0);
                    X4 = __builtin_amdgcn_mfma_f32_32x32x16_bf16(fk, fr, X4, 0, 0, 0);
                }
                const u32x4 mX0 = mkp[256], mX1 = mkp[257];
#pragma unroll
                for (int kb = 0; kb < 2; ++kb)
#pragma unroll
                    for (int s_ = 0; s_ < 2; ++s_) { bf16x8 fa, fs; RWC_PERM(fa, R0 + r32 * 72 + kb * 32 + 16 * s_ + 4 * hh); if (kb == 0) RWC_PACK(fs, S0, s_); else RWC_PACK(fs, S1, s_);
                        Ym = __builtin_amdgcn_mfma_f32_32x32x16_bf16(fa, fs, Ym, 0, 0, 0); }
#pragma unroll
                for (int s_ = 0; s_ < 2; ++s_) { bf16x8 fx3, fx4, fsa, fv; RWC_PACKM(fx3, X3, s_, mX0, mX1); RWC_PACKM(fx4, X4, s_, mX0, mX1);
                    RWC_PERM(fsa, SAT + (vt * 32 + r32) * 40 + 16 * s_ + 4 * hh); RWC_PERM(fv, VT + (vt * 32 + r32) * 40 + 16 * s_ + 4 * hh);
                    Ym = __builtin_amdgcn_mfma_f32_32x32x16_bf16(fx3, fsa, Ym, 0, 0, 0);
                    Ym = __builtin_amdgcn_mfma_f32_32x32x16_bf16(fx4, fv, Ym, 0, 0, 0); }
#pragma unroll
                for (int i = 0; i < 16; ++i) LY[((i & 3) + 8 * (i >> 2) + 4 * hh) * 64 + vt * 32 + r32] = Ym[i];
            }
            __builtin_amdgcn_sched_barrier(0);
#pragma unroll
            for (int q4 = 0; q4 < 4; ++q4) {
                const f32x4 g0 = *(const LAS f32x4*)(LGK + 8 * q4 + 4 * hh), g1 = *(const LAS f32x4*)(LGK + 32 + 8 * q4 + 4 * hh);
#pragma unroll
                for (int e = 0; e < 4; ++e) { S0[4 * q4 + e] *= g0[e]; S1[4 * q4 + e] *= g1[e]; }
            }
#pragma unroll
            for (int s_ = 0; s_ < 2; ++s_) {
                const bf16x8 fsa = *(const LAS bf16x8*)(SAT + (vt * 32 + r32) * 40 + 16 * s_ + 8 * hh), fv = *(const LAS bf16x8*)(VT + (vt * 32 + r32) * 40 + 16 * s_ + 8 * hh);
                const bf16x8 b0 = *(const LAS bf16x8*)(BBT + r32 * 40 + 16 * s_ + 8 * hh), b1 = *(const LAS bf16x8*)(BBT + (32 + r32) * 40 + 16 * s_ + 8 * hh);
                const bf16x8 k0 = *(const LAS bf16x8*)(KBT + r32 * 40 + 16 * s_ + 8 * hh), k1 = *(const LAS bf16x8*)(KBT + (32 + r32) * 40 + 16 * s_ + 8 * hh);
                S0 = __builtin_amdgcn_mfma_f32_32x32x16_bf16(b0, fsa, S0, 0, 0, 0); S0 = __builtin_amdgcn_mfma_f32_32x32x16_bf16(k0, fv, S0, 0, 0, 0);
                S1 = __builtin_amdgcn_mfma_f32_32x32x16_bf16(b1, fsa, S1, 0, 0, 0); S1 = __builtin_amdgcn_mfma_f32_32x32x16_bf16(k1, fv, S1, 0, 0, 0);
            }
#pragma unroll
            for (int q = 0; q < 4; ++q) { SST[q * 64] = (f32x4){S0[4 * q], S0[4 * q + 1], S0[4 * q + 2], S0[4 * q + 3]}; SST[(4 + q) * 64] = (f32x4){S1[4 * q], S1[4 * q + 1], S1[4 * q + 2], S1[4 * q + 3]}; }
#undef RWC_ROWFRAG
#undef RWC_PACK
#undef RWC_PACKM
#undef RWC_PERM
        } else {
          if (wave < 6 && seg == 1) {
              const int tq2 = tl - 128, p = tq2 >> 3, part = tq2 & 7;
              const f32x4 a0 = *(const LAS f32x4*)(CSV + p * 64 + 8 * part), a1 = *(const LAS f32x4*)(CSV + p * 64 + 8 * part + 4);
              const float tot = oct_sum((a0.x + a0.y) + (a0.z + a0.w) + (a1.x + a1.y) + (a1.z + a1.w));
              if (part == 0) CSC[(size_t)(rowbase + t0 + dir * p) * 8 + h] = tot;
          }
          if (cgi + 1 < 72 && !sk_conv) {
            const int tq = tl - 128; RW_PREA(cgi + 1, tq);
            { const int cn2 = cgi + 2 < 72 ? cgi + 2 : 71; RW_TAPS(tp0, cn2, tq); RW_LRAW(cn2, tq); }
          }
        }
        LDS_BARRIER();
    }
    if (!nostore) {
        RW_PTRS();
        RW_GEOM(71, segp, Lsp, rbp, t0p); (void)Lsp; (void)segp;
        const int dirp = d == 0 ? 1 : -1, s_ = tid >> 4, v0 = 4 * (tid & 15), t = t0p + dirp * s_;
        const f32x4 yv = *(const LAS f32x4*)(LY + s_ * 64 + v0);
        u32x2 w; w.x = cvtpk(yv.x, yv.y); w.y = cvtpk(yv.z, yv.w);
        *(GAS u32x2*)(YRW + (size_t)(rbp + t) * 512 + h * 64 + v0) = w;
    }
#undef RW_GEOM
#undef RW_LOAD0
#undef RW_TAPGEO
#undef RW_TAPQ
#undef RW_LRAW
#undef RW_LOAD1
#undef RW_CONV2
#undef RW_CONV_EPI
#undef RW_PREA
#undef RW_PTRS
    LDS_BARRIER();
}

template <int CTRL, int RMASK> __device__ __forceinline__ float dppz(float x) { return __builtin_bit_cast(float, __builtin_amdgcn_update_dpp(0, __builtin_bit_cast(int, x), CTRL, RMASK, 0xf, false)); }
__device__ __forceinline__ float scan32(float x) {
    x += dppz<0x111, 0xf>(x); x += dppz<0x112, 0xf>(x); x += dppz<0x114, 0xf>(x); x += dppz<0x118, 0xf>(x); x += dppz<0x142, 0xa>(x); return x;
}
template <int LANE> __device__ __forceinline__ float bcast32(float x) {
    return __builtin_bit_cast(float, __builtin_amdgcn_ds_swizzle(__builtin_bit_cast(int, x), LANE << 5));
}
__device__ __forceinline__ void hgrn_unit(Frame& F, int b, int h, int d) {
    LAUNDER(F);
    int tl0 = F.tid; asm volatile("" : "+v"(tl0));
    const int tid = tl0, wave = F.wave;
    const GAS bf16_t* CHG = (const GAS bf16_t*)(F.ws + WS_CHG);
    GAS bf16_t* OHG = (GAS bf16_t*)F.out + (size_t)2 * NT * 512 + (size_t)d * NT * 512;
    LAS unsigned char* LB_ = F.lds;
    constexpr int IMGB = 24320, O_KT2 = 4608, O_QH = 9216, O_KHT = 13824, O_IVT = 18944, O_LGK = 24064;
    LAS float* LO = (LAS float*)(LB_ + 2 * IMGB);
    const int pp = tid & 31, cs = (tid >> 5) & 1, wv = (wave - 4) & 3;
    const int c4a = 4 * (2 * wv + cs), c4b = c4a + 32;
    float lba[4], lbb[4];
#pragma unroll
    for (int e = 0; e < 4; ++e) { const int ca = h * 64 + c4a + e, cb = h * 64 + c4b + e;
        lba[e] = fsigmoid(F.inp[I_LB][(d * 2 + 0) * 512 + ca] - F.inp[I_LB][(d * 2 + 1) * 512 + ca]); lbb[e] = fsigmoid(F.inp[I_LB][(d * 2 + 0) * 512 + cb] - F.inp[I_LB][(d * 2 + 1) * 512 + cb]); }
    f32x16 S0, S1;
#pragma unroll
    for (int i = 0; i < 16; ++i) { S0[i] = 0.f; S1[i] = 0.f; }
    struct Raw { u32x2 qa, fa, ia, qb, fb, ib; };
    Raw rA, rB;
    rA.qa = rA.fa = rA.ia = rA.qb = rA.fb = rA.ib = (u32x2){0u, 0u}; rB = rA;
    f32x4 tvA[8], tvB[8];
#pragma unroll
    for (int i = 0; i < 8; ++i) { tvA[i] = (f32x4){0.f, 0.f, 0.f, 0.f}; tvB[i] = (f32x4){0.f, 0.f, 0.f, 0.f}; }
#define HG_LOAD(cg, R) do { const int seg_ = (cg) < 8 ? 0 : 1, Ls_ = seg_ == 0 ? CTXL : SEQ, rb_ = seg_ == 0 ? NT + b * CTXL : b * SEQ, ci_ = (cg) - (seg_ ? 8 : 0); \
        const int t_ = d == 0 ? ci_ * TCS + pp : Ls_ - 1 - ci_ * TCS - pp; const GAS bf16_t* rp = CHG + (size_t)(rb_ + t_) * LD_HG + h * 64 + c4a; \
        (R).qa = *(const GAS u32x2*)rp; (R).fa = *(const GAS u32x2*)(rp + 512 + d * 512); (R).ia = *(const GAS u32x2*)(rp + 1536); \
        (R).qb = *(const GAS u32x2*)(rp + 32); (R).fb = *(const GAS u32x2*)(rp + 32 + 512 + d * 512); (R).ib = *(const GAS u32x2*)(rp + 32 + 1536); } while (0)
#define HG_IMAGE(img, rq, rf, ri, lb, c4) do { \
        const float q_[4] = {bflo(rq.x), bfhi(rq.x), bflo(rq.y), bfhi(rq.y)}, f_[4] = {bflo(rf.x), bfhi(rf.x), bflo(rf.y), bfhi(rf.y)}; \
        float cum_[4], qs_[4], kf_[4]; \
        _Pragma("unroll") for (int e = 0; e < 4; ++e) { const float sg = fsigmoid(f_[e]); qs_[e] = fsilu(q_[e]) * 0.125f; cum_[e] = __builtin_amdgcn_logf(lb[e] + (1.0f - lb[e]) * sg); kf_[e] = (1.0f - lb[e]) * (1.0f - sg); } \
        _Pragma("unroll") for (int e = 0; e < 4; ++e) cum_[e] = scan32(cum_[e]); \
        float a_[4], b_[4], c_[4], d_[4], l_[4]; \
        _Pragma("unroll") for (int e = 0; e < 4; ++e) { const float ref = bcast32<16>(cum_[e]); \
            const float ecv = __builtin_amdgcn_exp2f(cum_[e] - ref), eicv = __builtin_amdgcn_exp2f(ref - cum_[e]), ehv = __builtin_amdgcn_exp2f(cum_[e]); \
            a_[e] = qs_[e] * ecv; b_[e] = kf_[e] * eicv; c_[e] = qs_[e] * ehv; \
            d_[e] = b_[e] * bcast32<31>(ecv);      \
            l_[e] = bcast32<31>(ehv); }              \
        *(LAS u32x2*)((img) + (pp * 72 + (c4)) * 2) = (u32x2){cvtpk(a_[0], a_[1]), cvtpk(a_[2], a_[3])}; \
        *(LAS u32x2*)((img) + O_KT2 + (pp * 72 + (c4)) * 2) = (u32x2){cvtpk(b_[0], b_[1]), cvtpk(b_[2], b_[3])}; \
        *(LAS u32x2*)((img) + O_QH + (pp * 72 + (c4)) * 2) = (u32x2){cvtpk(c_[0], c_[1]), cvtpk(c_[2], c_[3])}; \
        _Pragma("unroll") for (int e = 0; e < 4; ++e) *(LAS bf16_t*)((img) + O_KHT + (((c4) + e) * 40 + pp) * 2) = cvt1(d_[e]); \
        *(LAS bf16_t*)((img) + O_IVT + (((c4) + 0) * 40 + pp) * 2) = (bf16_t)(ri.x & 0xffffu); *(LAS bf16_t*)((img) + O_IVT + (((c4) + 1) * 40 + pp) * 2) = (bf16_t)(ri.x >> 16); \
        *(LAS bf16_t*)((img) + O_IVT + (((c4) + 2) * 40 + pp) * 2) = (bf16_t)(ri.y & 0xffffu); *(LAS bf16_t*)((img) + O_IVT + (((c4) + 3) * 40 + pp) * 2) = (bf16_t)(ri.y >> 16); \
        if (pp == 31) *(LAS f32x4*)((img) + O_LGK + (c4) * 4) = (f32x4){l_[0], l_[1], l_[2], l_[3]}; } while (0)
    LDS_BARRIER();
    if (wave >= 4) {
        HG_LOAD(0, rA);
        HG_LOAD(1, rB);
        HG_IMAGE(LB_, rA.qa, rA.fa, rA.ia, lba, c4a); HG_IMAGE(LB_, rA.qb, rA.fb, rA.ib, lbb, c4b);
        HG_LOAD(2, rA);
    }
    LDS_BARRIER();
#define HG_OUT(cg) do { if ((cg) >= 9) { int tl = tid; asm volatile("" : "+v"(tl));     \
            const int ci = (cg) - 9, t0 = d == 0 ? ci * TCS : SEQ - 1 - ci * TCS, dir = d == 0 ? 1 : -1; \
            _Pragma("unroll") for (int hf = 0; hf < 2; ++hf) { const int s = (tl >> 4) + 16 * hf, v0 = 4 * (tl & 15), t = t0 + dir * s; \
                const f32x4 yv = *(const LAS f32x4*)(LO + (((cg) - 1) & 1) * 2048 + s * 64 + v0); \
                u32x2 w; w.x = cvtpk(yv.x, yv.y); w.y = cvtpk(yv.z, yv.w); \
                *(GAS u32x2*)(OHG + (size_t)(b * SEQ + t) * 512 + h * 64 + v0) = w; } } } while (0)
    if (wave >= 4) {
#define HG_IMG_ITER(cg, R) do { if ((cg) + 1 < 72) { LAS unsigned char* img = LB_ + (((cg) + 1) & 1) * IMGB; \
            HG_IMAGE(img, (R).qa, (R).fa, (R).ia, lba, c4a); HG_IMAGE(img, (R).qb, (R).fb, (R).ib, lbb, c4b); \
            const int cn_ = (cg) + 3 < 72 ? (cg) + 3 : 71; HG_LOAD(cn_, R); } LDS_BARRIER(); } while (0)
#pragma unroll 1
        for (int cg2 = 0; cg2 < 72; cg2 += 2) { HG_IMG_ITER(cg2, rB); HG_IMG_ITER(cg2 + 1, rA); }
#undef HG_IMG_ITER
    } else if (wave < 2) {
#pragma unroll 1
      for (int cg = 0; cg < 72; ++cg) {
        HG_OUT(cg);
        int tl = tid; asm volatile("" : "+v"(tl));
        const int lane = tl & 63;
        {
            const int vt = wave, r32 = lane & 31, hh = lane >> 5;
            LAS unsigned char* img = LB_ + (cg & 1) * IMGB;
            const LAS bf16_t* QT = (const LAS bf16_t*)img; const LAS bf16_t* KT2 = (const LAS bf16_t*)(img + O_KT2); const LAS bf16_t* QH = (const LAS bf16_t*)(img + O_QH);
            const LAS bf16_t* KHT = (const LAS bf16_t*)(img + O_KHT); const LAS bf16_t* IVT = (const LAS bf16_t*)(img + O_IVT); const LAS float* LGK = (const LAS float*)(img + O_LGK);
            if (cg >= 8) {
                f32x16 X;
#pragma unroll
                for (int i = 0; i < 16; ++i) X[i] = 0.f;
#pragma unroll
                for (int s = 0; s < 4; ++s) {
                    const bf16x8 af = *(const LAS bf16x8*)(KT2 + r32 * 72 + 16 * s + 8 * hh), bf = *(const LAS bf16x8*)(QT + r32 * 72 + 16 * s + 8 * hh);
                    X = __builtin_amdgcn_mfma_f32_32x32x16_bf16(af, bf, X, 0, 0, 0);
                }
#pragma unroll
                for (int i = 0; i < 16; ++i) { const int j = (i & 3) + 8 * (i >> 2) + 4 * hh; if (j > r32) X[i] = 0.f; }
                f32x16 o;
#pragma unroll
                for (int i = 0; i < 16; ++i) o[i] = 0.f;
#pragma unroll
                for (int s = 0; s < 2; ++s) {
                    u32x4 xa; xa.x = cvtpk(X[8 * s + 0], X[8 * s + 1]); xa.y = cvtpk(X[8 * s + 2], X[8 * s + 3]); xa.z = cvtpk(X[8 * s + 4], X[8 * s + 5]); xa.w = cvtpk(X[8 * s + 6], X[8 * s + 7]);
                    const LAS bf16_t* ip = IVT + (vt * 32 + r32) * 40 + 16 * s + 4 * hh;
                    const u32x2 b0 = *(const LAS u32x2*)ip, b1 = *(const LAS u32x2*)(ip + 8);
                    const u32x4 bb = {b0.x, b0.y, b1.x, b1.y};
                    o = __builtin_amdgcn_mfma_f32_32x32x16_bf16(__builtin_bit_cast(bf16x8, xa), __builtin_bit_cast(bf16x8, bb), o, 0, 0, 0);
                }
#pragma unroll
                for (int kb = 0; kb < 2; ++kb)
#pragma unroll
                    for (int s = 0; s < 2; ++s) {
                        u32x4 sb;
                        if (kb == 0) { sb.x = cvtpk(S0[8 * s + 0], S0[8 * s + 1]); sb.y = cvtpk(S0[8 * s + 2], S0[8 * s + 3]); sb.z = cvtpk(S0[8 * s + 4], S0[8 * s + 5]); sb.w = cvtpk(S0[8 * s + 6], S0[8 * s + 7]); }
                        else { sb.x = cvtpk(S1[8 * s + 0], S1[8 * s + 1]); sb.y = cvtpk(S1[8 * s + 2], S1[8 * s + 3]); sb.z = cvtpk(S1[8 * s + 4], S1[8 * s + 5]); sb.w = cvtpk(S1[8 * s + 6], S1[8 * s + 7]); }
                        const LAS bf16_t* qp = QH + r32 * 72 + kb * 32 + 16 * s + 4 * hh;
                        const u32x2 a0 = *(const LAS u32x2*)qp, a1 = *(const LAS u32x2*)(qp + 8);
                        const u32x4 aa = {a0.x, a0.y, a1.x, a1.y};
                        o = __builtin_amdgcn_mfma_f32_32x32x16_bf16(__builtin_bit_cast(bf16x8, aa), __builtin_bit_cast(bf16x8, sb), o, 0, 0, 0);
                    }
                LAS float* LOw = LO + (cg & 1) * 2048;
#pragma unroll
                for (int i = 0; i < 16; ++i) { const int p = (i & 3) + 8 * (i >> 2) + 4 * hh; LOw[p * 64 + vt * 32 + r32] = o[i]; }
            }
#pragma unroll
            for (int q4 = 0; q4 < 4; ++q4) {
                const f32x4 g0 = *(const LAS f32x4*)(LGK + 8 * q4 + 4 * hh), g1 = *(const LAS f32x4*)(LGK + 32 + 8 * q4 + 4 * hh);
#pragma unroll
                for (int e = 0; e < 4; ++e) { S0[4 * q4 + e] *= g0[e]; S1[4 * q4 + e] *= g1[e]; }
            }
#pragma unroll
            for (int s = 0; s < 2; ++s) {
                const bf16x8 bf = *(const LAS bf16x8*)(IVT + (vt * 32 + r32) * 40 + 16 * s + 8 * hh);
                const bf16x8 a0 = *(const LAS bf16x8*)(KHT + r32 * 40 + 16 * s + 8 * hh), a1 = *(const LAS bf16x8*)(KHT + (32 + r32) * 40 + 16 * s + 8 * hh);
                S0 = __builtin_amdgcn_mfma_f32_32x32x16_bf16(a0, bf, S0, 0, 0, 0);
                S1 = __builtin_amdgcn_mfma_f32_32x32x16_bf16(a1, bf, S1, 0, 0, 0);
            }
        }
        LDS_BARRIER();
      }
    } else {
        LAS float* scr = (LAS float*)(F.lds + 75776 + (wave - 2) * 8448);
#define HG_CONV_ITER(cg, tv) do { HG_OUT(cg); const int lane_ = tid & 63; \
            if ((cg) >= 2) { const int idx = F.bid + F.G * ((wave - 2) + 2 * ((cg) - 2)); if (idx < NEXP_ITEMS) { const ExpItem it = exp_item(F, idx); tr_finish<true>(tv, it.K, it.N, it.WT, it.row_mul, it.row_add, scr, it.sub, lane_); } } \
            { int idx = F.bid + F.G * ((wave - 2) + 2 * (cg)); idx = idx < NEXP_ITEMS ? idx : NEXP_ITEMS - 1; const ExpItem it = exp_item(F, idx); tr_load<true>(it.W, it.N, it.sub, lane_, tv); } \
            LDS_BARRIER(); } while (0)
#pragma unroll 1
        for (int cg2 = 0; cg2 < 72; cg2 += 2) { HG_CONV_ITER(cg2, tvA); HG_CONV_ITER(cg2 + 1, tvB); }
#undef HG_CONV_ITER
    }
#undef HG_OUT
    {
        const int ci = 63, t0 = d == 0 ? ci * TCS : SEQ - 1 - ci * TCS, dir = d == 0 ? 1 : -1;
        const int s = tid >> 4, v0 = 4 * (tid & 15), t = t0 + dir * s;
        const f32x4 yv = *(const LAS f32x4*)(LO + (71 & 1) * 2048 + s * 64 + v0);
        u32x2 w; w.x = cvtpk(yv.x, yv.y); w.y = cvtpk(yv.z, yv.w);
        *(GAS u32x2*)(OHG + (size_t)(b * SEQ + t) * 512 + h * 64 + v0) = w;
    }
#undef HG_LOAD
#undef HG_IMAGE
    LDS_BARRIER();
}

__device__ __forceinline__ void post_phase(Frame& F) {
    LAUNDER(F);
    int tl_ = F.tid; asm volatile("" : "+v"(tl_));
    const int lane = tl_ & 63, wave = F.wave;
    GAS bf16_t* CRW = (GAS bf16_t*)(F.ws + WS_CRW);
    const GAS bf16_t* CHG = (const GAS bf16_t*)(F.ws + WS_CHG);
    const GAS bf16_t* G2T = (const GAS bf16_t*)(F.ws + WS_G2T);
    const GAS bf16_t* YRW = (const GAS bf16_t*)F.out; const GAS bf16_t* OHG = YRW + (size_t)2 * NT * 512;
    const GAS bf16_t* VCONV = (const GAS bf16_t*)(F.ws + WS_VCONV);
    const GAS float* CSC = (const GAS float*)(F.ws + WS_CSC);
    LAS float* LG = (LAS float*)F.lds;
    LAS bf16_t* SA = (LAS bf16_t*)(F.lds + 65536);
    const int c0 = 8 * lane, hd = lane >> 3;
    const int sr = lane & 31, hh = lane >> 5;
    LAS float* PC = (LAS float*)(F.lds + 65536 + 32 * 136 * 2);
    { const int t_ = tl_; PC[t_] = F.inp[I_LNG][t_]; PC[512 + t_] = F.inp[I_LNB][t_]; if (t_ < 64) PC[1024 + t_] = F.inp[I_HGN][t_]; }
    bf16x8 bfr[2][8];
#pragma unroll
    for (int ci = 0; ci < 2; ++ci) { const GAS bf16_t* bp = G2T + (size_t)((2 * wave + ci) * 32 + sr) * 128 + 8 * hh;
#pragma unroll
        for (int js = 0; js < 8; ++js) bfr[ci][js] = *(const GAS bf16x8*)(bp + 16 * js); }
    u32x4 gdn = *(const GAS u32x4*)(CRW + (size_t)(F.bid * 32 + 4 * wave + (lane >> 4)) * LD_RW + 1792 + 8 * (lane & 15));
#pragma unroll 1
  for (int tile = F.bid; tile < NT / 32; tile += F.G) {
    const int row0 = tile * 32;
    { const int r_ = 4 * wave + (lane >> 4), cc = 8 * (lane & 15);
      const u32x4 raw = gdn;
      { const int tn = tile + F.G < NT / 32 ? tile + F.G : tile; gdn = *(const GAS u32x4*)(CRW + (size_t)(tn * 32 + r_) * LD_RW + 1792 + cc); }
      float f[8] = {bflo(raw.x), bfhi(raw.x), bflo(raw.y), bfhi(raw.y), bflo(raw.z), bfhi(raw.z), bflo(raw.w), bfhi(raw.w)};
#pragma unroll
      for (int e = 0; e < 8; ++e) f[e] = fsigmoid(f[e]);
      *(LAS u32x4*)(SA + r_ * 136 + cc) = (u32x4){cvtpk(f[0], f[1]), cvtpk(f[2], f[3]), cvtpk(f[4], f[5]), cvtpk(f[6], f[7])}; }
    u32x4 ya[4], yb[4], vr[4], oa[4], ob[4], gr[4]; float csv[4];
#pragma unroll
    for (int i = 0; i < 4; ++i) { const int row = row0 + 4 * wave + i;
        ya[i] = *(const GAS u32x4*)(YRW + (size_t)row * 512 + c0); yb[i] = *(const GAS u32x4*)(YRW + (size_t)NT * 512 + (size_t)row * 512 + c0);
        vr[i] = *(const GAS u32x4*)(VCONV + (size_t)row * 512 + c0);
        oa[i] = *(const GAS u32x4*)(OHG + (size_t)row * 512 + c0); ob[i] = *(const GAS u32x4*)(OHG + (size_t)NT * 512 + (size_t)row * 512 + c0);
        gr[i] = *(const GAS u32x4*)(CHG + (size_t)row * LD_HG + 2048 + c0);
        csv[i] = CSC[(size_t)row * 8 + hd] + CSC[(size_t)NT * 8 + (size_t)row * 8 + hd]; }
    LDS_BARRIER();
    {
        f32x16 acc0, acc1;
#pragma unroll
        for (int i = 0; i < 16; ++i) { acc0[i] = 0.f; acc1[i] = 0.f; }
#pragma unroll
        for (int js = 0; js < 8; ++js) { const bf16x8 af = *(const LAS bf16x8*)(SA + sr * 136 + 16 * js + 8 * hh);
            acc0 = __builtin_amdgcn_mfma_f32_32x32x16_bf16(af, bfr[0][js], acc0, 0, 0, 0); acc1 = __builtin_amdgcn_mfma_f32_32x32x16_bf16(af, bfr[1][js], acc1, 0, 0, 0); }
#pragma unroll
        for (int i = 0; i < 16; ++i) { const int srow = (i & 3) + 8 * (i >> 2) + 4 * hh; LG[srow * 512 + (2 * wave) * 32 + sr] = acc0[i]; LG[srow * 512 + (2 * wave + 1) * 32 + sr] = acc1[i]; }
    }
    LDS_BARRIER();
#pragma unroll
    for (int i = 0; i < 4; ++i) {
        const int tl = 4 * wave + i, row = row0 + tl;
        float y[8] = {bflo(ya[i].x) + bflo(yb[i].x), bfhi(ya[i].x) + bfhi(yb[i].x), bflo(ya[i].y) + bflo(yb[i].y), bfhi(ya[i].y) + bfhi(yb[i].y), bflo(ya[i].z) + bflo(yb[i].z), bfhi(ya[i].z) + bfhi(yb[i].z), bflo(ya[i].w) + bflo(yb[i].w), bfhi(ya[i].w) + bfhi(yb[i].w)};
        float sm = 0.f;
#pragma unroll
        for (int e = 0; e < 8; ++e) sm += y[e];
        sm = oct_sum(sm);
        const float mu = sm * (1.f / 64.f);
        float sq = 0.f;
#pragma unroll
        for (int e = 0; e < 8; ++e) { const float dlt = y[e] - mu; sq += dlt * dlt; }
        sq = oct_sum(sq);
        const float rs = __builtin_amdgcn_rsqf(sq * (1.f / 64.f) + 64e-5f);
        const float cs = csv[i];
        const float vv[8] = {bflo(vr[i].x), bfhi(vr[i].x), bflo(vr[i].y), bfhi(vr[i].y), bflo(vr[i].z), bfhi(vr[i].z), bflo(vr[i].w), bfhi(vr[i].w)};
        const f32x4 g0 = *(const LAS f32x4*)(LG + tl * 512 + c0), g1 = *(const LAS f32x4*)(LG + tl * 512 + c0 + 4);
        const float gv[8] = {g0.x, g0.y, g0.z, g0.w, g1.x, g1.y, g1.z, g1.w};
        float o[8];
        const f32x4 lg0 = *(const LAS f32x4*)(PC + c0), lg1 = *(const LAS f32x4*)(PC + c0 + 4), lb0 = *(const LAS f32x4*)(PC + 512 + c0), lb1 = *(const LAS f32x4*)(PC + 512 + c0 + 4);
        const float lng[8] = {lg0.x, lg0.y, lg0.z, lg0.w, lg1.x, lg1.y, lg1.z, lg1.w}, lnb[8] = {lb0.x, lb0.y, lb0.z, lb0.w, lb1.x, lb1.y, lb1.z, lb1.w};
#pragma unroll
        for (int e = 0; e < 8; ++e) { const float yn = (y[e] - mu) * rs * lng[e] + lnb[e] + cs * vv[e]; o[e] = yn * gv[e]; }
        u32x4 w1; w1.x = cvtpk(o[0], o[1]); w1.y = cvtpk(o[2], o[3]); w1.z = cvtpk(o[4], o[5]); w1.w = cvtpk(o[6], o[7]);
        float z[8] = {bflo(oa[i].x) + bflo(ob[i].x), bfhi(oa[i].x) + bfhi(ob[i].x), bflo(oa[i].y) + bflo(ob[i].y), bfhi(oa[i].y) + bfhi(ob[i].y), bflo(oa[i].z) + bflo(ob[i].z), bfhi(oa[i].z) + bfhi(ob[i].z), bflo(oa[i].w) + bflo(ob[i].w), bfhi(oa[i].w) + bfhi(ob[i].w)};
        float zq = 0.f;
#pragma unroll
        for (int e = 0; e < 8; ++e) zq += z[e] * z[e];
        zq = oct_sum(zq);
        const float zr = __builtin_amdgcn_rsqf(zq * (1.f / 64.f) + 1e-6f);
        const float gg[8] = {bflo(gr[i].x), bfhi(gr[i].x), bflo(gr[i].y), bfhi(gr[i].y), bflo(gr[i].z), bfhi(gr[i].z), bflo(gr[i].w), bfhi(gr[i].w)};
        float p[8];
        const f32x4 hn0 = *(const LAS f32x4*)(PC + 1024 + (c0 & 63)), hn1 = *(const LAS f32x4*)(PC + 1024 + (c0 & 63) + 4);
        const float hgn[8] = {hn0.x, hn0.y, hn0.z, hn0.w, hn1.x, hn1.y, hn1.z, hn1.w};
#pragma unroll
        for (int e = 0; e < 8; ++e) p[e] = z[e] * zr * hgn[e] * fsilu(gg[e]);
        u32x4 w2; w2.x = cvtpk(p[0], p[1]); w2.y = cvtpk(p[2], p[3]); w2.z = cvtpk(p[4], p[5]); w2.w = cvtpk(p[6], p[7]);
        *(GAS u32x4*)(CRW + (size_t)row * LD_RW + c0) = w1;
        *(GAS u32x4*)(CRW + (size_t)row * LD_RW + 512 + c0) = w2;
    }
    LDS_BARRIER();
  }
}

__device__ __forceinline__ void route_phase(Frame& F) {
    LAUNDER(F);
    const int tid = F.tid, lane = F.lane, wave = F.wave, bid = F.bid;
    const GAS bf16_t* X1B = (const GAS bf16_t*)(F.ws + WS_X1B); const GAS float* MODF = (const GAS float*)(F.ws + WS_MODF); const GAS bf16_t* RWT = (const GAS bf16_t*)(F.ws + WS_RWT);
    GAS bf16_t* H2 = (GAS bf16_t*)(F.ws + WS_H2);
    int* SLOT = (int*)(F.ws + WS_SLOT); float* GATE = (float*)(F.ws + WS_GATE); int* TOKL = (int*)(F.ws + WS_TOKL);
    const int tok0 = bid * 128, b = bid >> 4, chunk = bid / (256 / NCH);
    LAS float* gs = (LAS float*)F.lds;
    LAS float* sh = gs + 1024;
    LAS float* rs = gs + 2048;
    LAS float* LGT = gs + 2304;
    LAS float* LGT2 = LGT + 128 * 65;
    LAS int* lcnt = (LAS int*)(gs + 2304 + 2 * 128 * 65);
    LAS int* gbase = lcnt + 64;
    LAS int* lsl = gbase + 64;
    for (int c = tid; c < DM; c += 512) { gs[c] = F.inp[I_N2G][c] * (1.0f + MODF[(size_t)b * NMOD + 4 * DM + c]); sh[c] = MODF[(size_t)b * NMOD + 3 * DM + c]; }
    if (tid < 64) lcnt[tid] = 0;
    __syncthreads();
    for (int r0 = wave; r0 < 128; r0 += 32) {
        u32x4 raw[4][2];
#pragma unroll
        for (int q = 0; q < 4; ++q) { const GAS u32x4* xr = (const GAS u32x4*)(X1B + (size_t)(tok0 + r0 + 8 * q) * DM) + lane; raw[q][0] = xr[0]; raw[q][1] = xr[64]; }
#pragma unroll
        for (int q = 0; q < 4; ++q) {
            const int r = r0 + 8 * q;
            float v[16]; float s = 0.f;
#pragma unroll
            for (int j = 0; j < 2; ++j) { const u32x4 w = raw[q][j];
                v[8 * j + 0] = bflo(w.x); v[8 * j + 1] = bfhi(w.x); v[8 * j + 2] = bflo(w.y); v[8 * j + 3] = bfhi(w.y); v[8 * j + 4] = bflo(w.z); v[8 * j + 5] = bfhi(w.z); v[8 * j + 6] = bflo(w.w); v[8 * j + 7] = bfhi(w.w); }
#pragma unroll
            for (int e = 0; e < 16; ++e) s += v[e] * v[e];
            const float rstd = __builtin_amdgcn_rsqf(wave_sum(s) * (1.f / DM) + 1e-6f);
            if (lane == 0) rs[r] = rstd;
            GAS u32x4* o8 = (GAS u32x4*)(H2 + (size_t)(tok0 + r) * DM) + lane;
#pragma unroll
            for (int j = 0; j < 2; ++j) { const int c = 8 * lane + 512 * j; const f32x4 g0 = *(const LAS f32x4*)(gs + c), g1 = *(const LAS f32x4*)(gs + c + 4), h0 = *(const LAS f32x4*)(sh + c), h1 = *(const LAS f32x4*)(sh + c + 4);
                u32x4 w; w.x = cvtpk(v[8 * j + 0] * rstd * g0.x + h0.x, v[8 * j + 1] * rstd * g0.y + h0.y); w.y = cvtpk(v[8 * j + 2] * rstd * g0.z + h0.z, v[8 * j + 3] * rstd * g0.w + h0.w);
                w.z = cvtpk(v[8 * j + 4] * rstd * g1.x + h1.x, v[8 * j + 5] * rstd * g1.y + h1.y); w.w = cvtpk(v[8 * j + 6] * rstd * g1.z + h1.z, v[8 * j + 7] * rstd * g1.w + h1.w); o8[64 * j] = w; }
        }
    }
    __syncthreads();
    {
        const int tt = wave >> 1, kh = wave & 1, i = lane & 31, hh = lane >> 5;
        const GAS bf16_t* xa = X1B + (size_t)(tok0 + tt * 32 + i) * DM + 512 * kh + 8 * hh;
        const GAS bf16_t* wh = RWT + (size_t)i * DM + 512 * kh + 8 * hh;
        const float rstd = rs[tt * 32 + i];
        f32x16 acc0, acc1;
#pragma unroll
        for (int q = 0; q < 16; ++q) { acc0[q] = 0.f; acc1[q] = 0.f; }
#pragma unroll 4
        for (int st = 0; st < 32; ++st) {
            const u32x4 xw = *(const GAS u32x4*)(xa + 16 * st);
            const bf16x8 w0h = *(const GAS bf16x8*)(wh + 16 * st), w0l = *(const GAS bf16x8*)(wh + 65536 + 16 * st), w1h = *(const GAS bf16x8*)(wh + 32 * DM + 16 * st), w1l = *(const GAS bf16x8*)(wh + 65536 + 32 * DM + 16 * st);
            const LAS float* gp = gs + 512 * kh + 16 * st + 8 * hh; const LAS float* hp = sh + 512 * kh + 16 * st + 8 * hh;
            const f32x4 g0 = *(const LAS f32x4*)gp, g1 = *(const LAS f32x4*)(gp + 4), h0 = *(const LAS f32x4*)hp, h1 = *(const LAS f32x4*)(hp + 4);
            float hv[8] = {bflo(xw.x) * rstd * g0.x + h0.x, bfhi(xw.x) * rstd * g0.y + h0.y, bflo(xw.y) * rstd * g0.z + h0.z, bfhi(xw.y) * rstd * g0.w + h0.w,
                           bflo(xw.z) * rstd * g1.x + h1.x, bfhi(xw.z) * rstd * g1.y + h1.y, bflo(xw.w) * rstd * g1.z + h1.z, bfhi(xw.w) * rstd * g1.w + h1.w};
            u32x4 ph; ph.x = cvtpk(hv[0], hv[1]); ph.y = cvtpk(hv[2], hv[3]); ph.z = cvtpk(hv[4], hv[5]); ph.w = cvtpk(hv[6], hv[7]);
            u32x4 pl; pl.x = cvtpk(hv[0] - bflo(ph.x), hv[1] - bfhi(ph.x)); pl.y = cvtpk(hv[2] - bflo(ph.y), hv[3] - bfhi(ph.y)); pl.z = cvtpk(hv[4] - bflo(ph.z), hv[5] - bfhi(ph.z)); pl.w = cvtpk(hv[6] - bflo(ph.w), hv[7] - bfhi(ph.w));
            const bf16x8 ah = __builtin_bit_cast(bf16x8, ph), al = __builtin_bit_cast(bf16x8, pl);
            acc0 = __builtin_amdgcn_mfma_f32_32x32x16_bf16(ah, w0h, acc0, 0, 0, 0); acc1 = __builtin_amdgcn_mfma_f32_32x32x16_bf16(ah, w1h, acc1, 0, 0, 0);
            acc0 = __builtin_amdgcn_mfma_f32_32x32x16_bf16(ah, w0l, acc0, 0, 0, 0); acc1 = __builtin_amdgcn_mfma_f32_32x32x16_bf16(ah, w1l, acc1, 0, 0, 0);
            acc0 = __builtin_amdgcn_mfma_f32_32x32x16_bf16(al, w0h, acc0, 0, 0, 0); acc1 = __builtin_amdgcn_mfma_f32_32x32x16_bf16(al, w1h, acc1, 0, 0, 0);
        }
        LAS float* LT = kh == 0 ? LGT : LGT2;
#pragma unroll
        for (int q = 0; q < 16; ++q) { const int trow = (q & 3) + 8 * (q >> 2) + 4 * hh; LT[(tt * 32 + trow) * 65 + i] = acc0[q]; LT[(tt * 32 + trow) * 65 + 32 + i] = acc1[q]; }
    }
    __syncthreads();
    const float rbias = F.inp[I_RB][lane];
    for (int r = wave; r < 128; r += 8) {
        const float score = sigmoidf_(LGT[r * 65 + lane] + LGT2[r * 65 + lane]);
        const float sel = score + rbias;
        const float m1 = oct_max(sel);
        const int i1 = oct_min((sel == m1) ? (lane & 7) : 99);
        const float m2 = oct_max(((lane & 7) == i1) ? -INFINITY : sel);
        const float gsc = m1 + m2;
        const int gme = lane >> 3; int rank = 0;
#pragma unroll
        for (int gq = 0; gq < 8; ++gq) { const float og = rdl(gsc, gq * 8); rank += (og > gsc || (og == gsc && gq < gme)) ? 1 : 0; }
        float msk = (rank < 4) ? sel : -INFINITY;
        bool chosen = false; int myj = 0;
#pragma unroll 1
        for (int j = 0; j < 8; ++j) {
            const float mx = wave_max(msk);
            const unsigned long long bal = __ballot(msk == mx);
            const int win = __ffsll((long long)bal) - 1;
            if (lane == win) { chosen = true; myj = j; msk = -INFINITY; }
        }
        const float gsum = wave_sum(chosen ? score : 0.f);
        if (chosen) {
            const float gate = score / gsum * 2.5f;
            const int lpos = atomicAdd((int*)&lcnt[lane], 1);
            lsl[r * 8 + myj] = lane | (lpos << 8);
            GATE[(size_t)(tok0 + r) * 8 + myj] = gate;
        }
    }
    __syncthreads();
    if (tid < 64) gbase[tid] = (int)__hip_atomic_fetch_add((unsigned*)(F.ctl + CW_GCNT) + chunk * 64 + tid, (unsigned)lcnt[tid], RLX_AGENT);
    __syncthreads();
    for (int q = tid; q < 128 * 8; q += 512) {
        const int v = lsl[q], e = v & 255, pos = gbase[e] + (v >> 8), r = q >> 3;
        TOKL[((size_t)chunk * 64 + e) * CAPE + pos] = tok0 + r;
        SLOT[(size_t)(tok0 + r) * 8 + (q & 7)] = e | (pos << 8);
    }
    __syncthreads();
}

__device__ __forceinline__ void moe_tables(Frame& F, int chunk, LAS int* tb) {
    if (F.tid < 65) tb[F.tid] = F.tid < 64 ? (int)__hip_atomic_load((unsigned*)(F.ctl + CW_GCNT) + chunk * 64 + F.tid, RLX_AGENT) : TCH;
    __syncthreads();
    if (F.tid == 0) {
        int ro = 0, bp = 0;
#pragma unroll 1
        for (int e = 0; e < 65; ++e) { const int nb = (tb[e] + 255) >> 8; tb[72 + e] = ro; tb[144 + e] = bp; ro += nb * 256; bp += nb; }
        tb[72 + 65] = ro; tb[144 + 65] = bp;
    }
    __syncthreads();
}
__device__ __forceinline__ int moe_units(Frame& F, int chunk, int npn, bool g1, LAS int* tb, LAS int* ul) {
    const int nblk = tb[144 + 65], nun = nblk * npn;
    const int G = F.G, c = F.bid;
    const int n = (nun > c) ? (nun - c + G - 1) / G : 0;
    if (F.tid < n) {
        int wg = F.tid * G + c;
        { const int q = nun / 8, r = nun % 8, xcd = wg % 8, off = wg / 8; wg = (xcd < r ? xcd * (q + 1) : r * (q + 1) + (xcd - r) * q) + off; }
        const int bg = wg / npn, pn = wg % npn;
        int e = 0;
#pragma unroll 1
        while (e < 64 && tb[144 + e + 1] <= bg) ++e;
        const int blk = bg - tb[144 + e], cnt = tb[e], nvalid = min(256, cnt - blk * 256), orow = tb[72 + e] + blk * 256;
        LAS int* p = ul + F.tid * 8;
        if (g1) { p[0] = chunk * TCH + blk * 256; p[1] = e * 512 + pn * 256; p[2] = (e < 64) ? ((chunk * 64 + e) * CAPE + blk * 256) : -1; p[3] = nvalid; p[4] = orow; p[5] = pn; p[6] = e; p[7] = 0; }
        else { p[0] = orow; p[1] = e * 1024 + pn * 256; p[2] = 0; p[3] = 256; p[4] = orow; p[5] = pn; p[6] = e; p[7] = 0; }
    }
    __syncthreads();
    return n;
}
__device__ __forceinline__ void combine_chunk(Frame& F, int chunk, LAS int* tb) {
    LAUNDER(F);
    const int lane = F.lane, wave = F.wave;
    const GAS unsigned char* Y = (const GAS unsigned char*)(F.ws + WS_Y);
    const GAS int* SLOT = (const GAS int*)(F.ws + WS_SLOT); const GAS float* GATE = (const GAS float*)(F.ws + WS_GATE); const GAS float* MODF = (const GAS float*)(F.ws + WS_MODF);
    const GAS bf16_t* X1B = (const GAS bf16_t*)(F.ws + WS_X1B); GAS float* OUT = (GAS float*)F.out;
    float pscale = 1.0f;
    if (PROBE_K >= 0 && chunk == NCH - 1) { const unsigned long long* ts = (const unsigned long long*)(F.ctl + CW_TS); const float tus = (float)(ts[PROBE_K + 1] - ts[PROBE_K]) * 0.01f; pscale = 1.0f + sqrtf(tus * 1e-3f); }
    constexpr int TPW = TCH / 256;
#pragma unroll 1
    for (int r = wave; r < TPW; r += 8) {
        const int tok = chunk * TCH + F.bid * TPW + r, b = tok >> 11;
        u32x4 yw[9]; float gt[9];
#pragma unroll
        for (int j = 0; j < 9; ++j) {
            int rowi;
            if (j < 8) { const int v = SLOT[(size_t)tok * 8 + j]; rowi = tb[72 + (v & 255)] + (v >> 8); gt[j] = GATE[(size_t)tok * 8 + j]; }
            else { rowi = tb[72 + 64] + (tok - chunk * TCH); gt[j] = 1.0f; }
            yw[j] = *(const GAS u32x4*)(Y + (size_t)rowi * DM + 16 * lane);
        }
        GAS f32x4* xr = (GAS f32x4*)(OUT + (size_t)tok * DM + 16 * lane);
        const GAS f32x4* g2 = (const GAS f32x4*)(MODF + (size_t)b * NMOD + 5 * DM + 16 * lane);
        const u32x4 xb0 = *(const GAS u32x4*)(X1B + (size_t)tok * DM + 16 * lane), xb1 = *(const GAS u32x4*)(X1B + (size_t)tok * DM + 16 * lane + 8);
        const f32x4 xv[4] = {{bflo(xb0.x), bfhi(xb0.x), bflo(xb0.y), bfhi(xb0.y)}, {bflo(xb0.z), bfhi(xb0.z), bflo(xb0.w), bfhi(xb0.w)}, {bflo(xb1.x), bfhi(xb1.x), bflo(xb1.y), bfhi(xb1.y)}, {bflo(xb1.z), bfhi(xb1.z), bflo(xb1.w), bfhi(xb1.w)}};
        f32x4 acc[4];
#pragma unroll
        for (int q = 0; q < 4; ++q) acc[q] = (f32x4){0.f, 0.f, 0.f, 0.f};
#pragma unroll
        for (int j = 0; j < 9; ++j) {
            const unsigned ww[4] = {yw[j].x, yw[j].y, yw[j].z, yw[j].w};
#pragma unroll
            for (int q = 0; q < 4; ++q) { const f32x2 lo = __builtin_amdgcn_cvt_pk_f32_fp8((int)ww[q], false), hi = __builtin_amdgcn_cvt_pk_f32_fp8((int)ww[q], true);
                acc[q].x += gt[j] * lo.x; acc[q].y += gt[j] * lo.y; acc[q].z += gt[j] * hi.x; acc[q].w += gt[j] * hi.y; }
        }
        f32x4 v[4]; float s = 0.f;
#pragma unroll
        for (int q = 0; q < 4; ++q) { v[q] = xv[q] + g2[q] * acc[q]; s += (v[q].x * v[q].x + v[q].y * v[q].y) + (v[q].z * v[q].z + v[q].w * v[q].w); }
        const float rstd = __builtin_amdgcn_rsqf(wave_sum(s) * (1.f / DM) + 1e-6f);
        const GAS f32x4* fg = (const GAS f32x4*)F.inp[I_FNG] + 4 * lane;
#pragma unroll
        for (int q = 0; q < 4; ++q) xr[q] = v[q] * (rstd * pscale) * fg[q];
    }
}

constexpr int NPHASE = 8 + 2 * NCH;
struct Args { const float* in[32]; float* out; unsigned char* ws; int ph_lo, ph_hi, li, pad; };
__global__ void __launch_bounds__(512, 2) fwd_kernel(Args args) {
    extern __shared__ __attribute__((aligned(16))) unsigned char lds[];
    Frame F;
    F.lds = (LAS unsigned char*)lds;
    F.MISC = (volatile LAS unsigned*)(F.lds + MISC_OFF);
    F.tid = threadIdx.x; F.lane = F.tid & 63; F.wave = __builtin_amdgcn_readfirstlane(F.tid >> 6);
    F.G = gridDim.x; F.bid = blockIdx.x;
    F.inp = (const gcf __attribute__((address_space(4)))*)__builtin_amdgcn_kernarg_segment_ptr();
    F.out = args.out; F.ws = args.ws;
    F.ctl = (gu32*)(args.ws + WS_CTL);
    for (int u = F.tid; u < (LDS_BYTES - LDSCTL_OFF) / 4; u += 512) ((LAS unsigned*)(F.lds + LDSCTL_OFF))[u] = 0u;
    __syncthreads();
    XcdBarrier bar; bar.bar = (unsigned*)(F.ctl + CW_BAR); bar.x = 0; bar.st = nullptr;
    if (MK_N_LAUNCHES == 1) bar = xcd_barrier_post((unsigned*)(F.ctl + CW_BAR), F.MISC + 8);
    const int lo = args.ph_lo, hi = args.ph_hi;
    LAS int* tb = (LAS int*)(F.lds + TBL_OFF);
    LAS int* ul = tb + 256;
#ifndef PH_MASK
#define PH_MASK 0xFFFF
#endif
    int dup = 0;
    const int wave_s = __builtin_amdgcn_readfirstlane((int)threadIdx.x >> 6);
#pragma unroll 1
    for (int ph = lo; ph < hi; ++ph) {
        LAUNDER(F); F.dup = dup;
        { int tid_ = wave_s * 64 + (int)__builtin_amdgcn_mbcnt_hi(~0u, __builtin_amdgcn_mbcnt_lo(~0u, 0u)); asm volatile("" : "+v"(tid_)); F.tid = tid_; F.lane = tid_ & 63; F.wave = wave_s;
          int bid_ = blockIdx.x, g_ = gridDim.x; asm volatile("" : "+s"(bid_), "+s"(g_)); F.bid = bid_; F.G = g_; }
        const int phm = ph;
        if (PROBE_K >= 0 && F.bid == 0 && F.tid == 0) { ((unsigned long long*)(F.ctl + CW_TS))[ph] = __builtin_amdgcn_s_memrealtime(); }
#define PHB(k) ((PH_MASK >> (k)) & 1)
        if (phm == 0 && PHB(0)) { p0a(F); }
        else if (phm == 1 && PHB(1)) { p0b(F); }
        else if (phm == 2 && PHB(2)) {
            pg8::Gemm g{(const bf16_t*)F.out, (const bf16_t*)(F.ws + WS_WIN), nullptr, DM, DM}; pg8::InProjOrder S; S.init(F.G, F.bid);
            pg8::EpiCols E{(GAS bf16_t*)(F.ws + WS_CRW), (GAS bf16_t*)(F.ws + WS_CHG)};
            pg8::gemm_phase<pg8::EpiCols, pg8::InProjOrder, false, true>(F.lds, g, S, E, F.tid);
        }
        else if (phm == 3 && PHB(3)) {
#pragma unroll 1
            for (int u = F.bid; u < 256; u += F.G) { if (!(F.dup && (DUP_MODE == 2 || DUP_MODE >= 9))) rwkv_unit(F, u >> 4, (u >> 1) & 7, u & 1); if (!(F.dup && DUP_MODE != 0 && DUP_MODE != 2 && DUP_MODE < 9)) hgrn_unit(F, u >> 4, (u >> 1) & 7, u & 1); }
        }
        else if (phm == 4 && PHB(4)) {
            post_phase(F);
        }
        else if (phm == 5 && PHB(5)) {
            pg8::Gemm g{(const bf16_t*)(F.ws + WS_CRW), (const bf16_t*)(F.ws + WS_WOUT), nullptr, LD_RW, DM}; pg8::StaticOrder S; S.init(NT, DM, F.G, F.bid);
            pg8::EpiX1 E{F.inp[I_X], (gcf)(F.ws + WS_MODF), (GAS bf16_t*)(F.ws + WS_X1B)};
            pg8::gemm_phase<pg8::EpiX1, pg8::StaticOrder, false, true>(F.lds, g, S, E, F.tid);
        }
        else if (phm == 6 && PHB(6)) { route_phase(F); }
        else if (phm >= 7) {
            const bool odd = (phm & 1) != 0;
            if (odd && phm >= 9 && PHB(9)) {
                const int c = (phm - 9) >> 1;
                __syncthreads();
                moe_tables(F, c, tb);
                combine_chunk(F, c, tb);
                __syncthreads();
            }
            if (odd && phm <= 5 + 2 * NCH && PHB(7)) {
                const int c = (phm - 7) >> 1;
                LAUNDER(F);
                __syncthreads();
                moe_tables(F, c, tb);
                const int n = moe_units(F, c, 2, true, tb, ul);
                pg8::Gemm g{(const bf16_t*)(F.ws + WS_H2), (const bf16_t*)(F.ws + WS_W1E), (const int*)(F.ws + WS_TOKL), DM, DM};
                pg8::ListOrder S{ul, n}; pg8::EpiSwiglu E{(GAS bf16_t*)(F.ws + WS_ACT)};
                pg8::gemm_phase<pg8::EpiSwiglu, pg8::ListOrder, true, true>(F.lds, g, S, E, F.tid);
            }
            if (!odd && PHB(8)) {
                const int c = (phm - 8) >> 1;
                __syncthreads();
                moe_tables(F, c, tb);
                const int n = moe_units(F, c, 4, false, tb, ul);
                pg8::Gemm g{(const bf16_t*)(F.ws + WS_ACT), (const bf16_t*)(F.ws + WS_W2E), nullptr, 256, 256};
                pg8::ListOrder S{ul, n}; pg8::EpiFp8 E{(GAS unsigned char*)(F.ws + WS_Y)};
                pg8::gemm_phase<pg8::EpiFp8, pg8::ListOrder, false, true>(F.lds, g, S, E, F.tid);
            }
        }
        if (ph + 1 < hi) xcd_barrier(bar);
        if (DUP_PH >= 0 && ph == DUP_PH && dup == 0) { dup = 1; --ph; }
    }
}

extern "C" void kernel_launch(void* const* d_in, const int* in_sizes, int n_in, void* d_out, int out_size, void* d_ws, size_t ws_size, hipStream_t stream) {
    static int grid = 0;
    if (grid == 0) {
        if (n_in != 32 || out_size != NT * DM || ws_size < WS_END) { fprintf(stderr, "kernel_launch: unexpected shapes: n_in %d out %d ws %zu\n", n_in, out_size, ws_size); grid = -1; return; }
        int dev = 0, cus = 0, per_cu = 0;
        if (hipGetDevice(&dev) != hipSuccess || hipDeviceGetAttribute(&cus, hipDeviceAttributeMultiprocessorCount, dev) != hipSuccess) { grid = -1; return; }
        if (hipFuncSetAttribute((const void*)fwd_kernel, hipFuncAttributeMaxDynamicSharedMemorySize, LDS_BYTES) != hipSuccess) { fprintf(stderr, "kernel_launch: hipFuncSetAttribute failed\n"); grid = -1; return; }
        if (hipOccupancyMaxActiveBlocksPerMultiprocessor(&per_cu, (const void*)fwd_kernel, 512, LDS_BYTES) != hipSuccess || per_cu < 1)
            fprintf(stderr, "kernel_launch: occupancy query reports %d workgroups per CU\n", per_cu);
        (void)hipGetLastError();
        grid = cus;
        if (grid != 256) fprintf(stderr, "kernel_launch: %d CUs (built for 256)\n", grid);
    }
    if (grid < 0) return;
    if (hipMemsetAsync((char*)d_ws + WS_CTL, 0, CTL_ZERO_BYTES, stream) != hipSuccess) { fprintf(stderr, "kernel_launch: memset failed\n"); return; }
    Args a{};
    for (int i = 0; i < 32; ++i) a.in[i] = (const float*)d_in[i];
    a.out = (float*)d_out; a.ws = (unsigned char*)d_ws;
    if (MK_N_LAUNCHES == 1) {
        a.ph_lo = 0; a.ph_hi = NPHASE; a.li = 0;
        hipLaunchKernelGGL(fwd_kernel, dim3(grid), dim3(512), LDS_BYTES, stream, a);
    } else {
        for (int p = 0; p < NPHASE; ++p) { a.ph_lo = p; a.ph_hi = p + 1; a.li = p; hipLaunchKernelGGL(fwd_kernel, dim3(grid), dim3(512), LDS_BYTES, stream, a); }
    }
    const hipError_t le = hipPeekAtLastError();
    if (le != hipSuccess) fprintf(stderr, "kernel_launch: launch failed: %s\n", hipGetErrorName(le));
}
```

```cpp
#include <hip/hip_runtime.h>
#include <cstdio>
#include <cstdint>

#ifndef MK_N_LAUNCHES
#define MK_N_LAUNCHES 1
#endif

#define GAS __attribute__((address_space(1)))
#define LAS __attribute__((address_space(3)))
typedef unsigned short bf16_t;
typedef short bf16x8 __attribute__((ext_vector_type(8)));
typedef float f32x4 __attribute__((ext_vector_type(4)));
typedef float f32x2 __attribute__((ext_vector_type(2)));
typedef float f32x16 __attribute__((ext_vector_type(16)));
typedef unsigned u32x4 __attribute__((ext_vector_type(4)));
typedef unsigned u32x2 __attribute__((ext_vector_type(2)));
typedef GAS unsigned gu32;
typedef const GAS float* gcf;

constexpr int NB = 16, SEQ = 2048, DM = 1024, CTXL = 256, NT = NB * SEQ, NTC = NB * CTXL, MROWS = NT + NTC;
constexpr int LD_RW = 2048, LD_HG = 2560, N_IN = 4608, P_IN = 4480;
constexpr int NEXP = 64, NCH = 2, TCH = NT / NCH, CAPE = TCH;
constexpr int NMOD = 6 * DM;
constexpr int TCS = 32;
constexpr int ROWS_CH = 164096;

constexpr size_t MiB = 1u << 20;
constexpr size_t WS_CTL = 0, CTL_ZERO_BYTES = 1 * MiB;
constexpr size_t WS_MODF = 1 * MiB;
constexpr size_t WS_MODP = 2 * MiB;
constexpr size_t WS_RWT = 9 * MiB;
constexpr size_t WS_G2T = 9 * MiB + 512 * 1024;
constexpr size_t WS_WIN = 10 * MiB;
constexpr size_t WS_WOUT = 19 * MiB;
constexpr size_t WS_W1E = 21 * MiB;
constexpr size_t WS_W2E = 86 * MiB;
constexpr size_t WS_SLOT = 119 * MiB;
constexpr size_t WS_GATE = 120 * MiB;
constexpr size_t WS_TOKL = 121 * MiB;
constexpr size_t WS_BIG = 130 * MiB;
constexpr size_t WS_CRW = WS_BIG;
constexpr size_t WS_CHG = WS_BIG + 144 * MiB;
constexpr size_t WS_VCONV = WS_BIG + 324 * MiB;
constexpr size_t WS_CSC = WS_BIG + 356 * MiB;
constexpr size_t WS_H2 = WS_BIG;
constexpr size_t WS_ACT = WS_BIG + 64 * MiB;
constexpr size_t WS_Y = WS_BIG + 146 * MiB;
constexpr size_t WS_X1B = WS_BIG + 308 * MiB;
constexpr size_t WS_END = 512 * MiB;
static_assert(WS_X1B >= WS_Y + (size_t)ROWS_CH * 1024 && WS_X1B + (size_t)NT * DM * 2 <= WS_END && WS_CSC + 2 * MiB <= WS_END && WS_Y + (size_t)ROWS_CH * 1024 <= WS_END && WS_ACT + (size_t)ROWS_CH * 512 <= WS_Y, "ws map");
constexpr int CW_TMO = 0, CW_CODE = 1, CW_BAR = 4096, CW_GCNT = 16384, CW_TS = 20480;
#ifndef DUP_PH
#define DUP_PH -1
#endif
#ifndef RW_CHUNKED
#define RW_CHUNKED 1
#endif
#ifndef DUP_MODE
#define DUP_MODE 0
#endif
#ifndef PROBE_K
#define PROBE_K -1
#endif

constexpr int RING_BYTES = 131072;
constexpr int LDSCTL_OFF = RING_BYTES, MISC_OFF = LDSCTL_OFF + 320, TBL_OFF = LDSCTL_OFF + 1024;
constexpr int LDS_BYTES = 147456;

#define RLX_AGENT __ATOMIC_RELAXED, __HIP_MEMORY_SCOPE_AGENT
#define LDS_WAIT() asm volatile("s_waitcnt lgkmcnt(0)" ::: "memory")
#define VM_WAIT() asm volatile("s_waitcnt vmcnt(0)" ::: "memory")
#define LDS_BARRIER() do { asm volatile("s_waitcnt lgkmcnt(0)" ::: "memory"); __builtin_amdgcn_s_barrier(); asm volatile("" ::: "memory"); } while (0)
__device__ __forceinline__ unsigned f2bf(float f) { unsigned u = __builtin_bit_cast(unsigned, f); return (u + 0x7fffu + ((u >> 16) & 1u)) >> 16; }
__device__ __forceinline__ unsigned pk2(float lo, float hi) { return f2bf(lo) | (f2bf(hi) << 16); }
__device__ __forceinline__ float bf2f(unsigned short h) { return __builtin_bit_cast(float, (unsigned)h << 16); }
__device__ __forceinline__ float bflo(unsigned w) { return __builtin_bit_cast(float, w << 16); }
__device__ __forceinline__ float bfhi(unsigned w) { return __builtin_bit_cast(float, w & 0xffff0000u); }
__device__ __forceinline__ float sigmoidf_(float x) { return 1.0f / (1.0f + __expf(-x)); }
__device__ __forceinline__ float siluf_(float x) { return x / (1.0f + __expf(-x)); }
typedef __bf16 bf16x2_t __attribute__((ext_vector_type(2)));
__device__ __forceinline__ unsigned cvtpk(float lo, float hi) { const f32x2 v = {lo, hi}; const bf16x2_t b = __builtin_convertvector(v, bf16x2_t); return __builtin_bit_cast(unsigned, b); }
__device__ __forceinline__ unsigned short cvt1(float x) { return (unsigned short)(cvtpk(x, 0.f) & 0xffffu); }
__device__ __forceinline__ float fexp(float x) { return __builtin_amdgcn_exp2f(x * 1.4426950408889634f); }
__device__ __forceinline__ float fsigmoid(float x) { return __builtin_amdgcn_rcpf(1.0f + fexp(-x)); }
__device__ __forceinline__ float fsilu(float x) { return x * fsigmoid(x); }
__device__ __forceinline__ float ftanh(float x) { return 1.0f - 2.0f * __builtin_amdgcn_rcpf(1.0f + fexp(2.0f * x)); }
template <int CTRL> __device__ __forceinline__ float dppf(float x) { return __builtin_bit_cast(float, __builtin_amdgcn_update_dpp(0, __builtin_bit_cast(int, x), CTRL, 0xf, 0xf, true)); }
__device__ __forceinline__ float row16_sum(float x) {
    x += dppf<0xB1>(x);
    x += dppf<0x4E>(x);
    x += dppf<0x141>(x);
    x += dppf<0x140>(x);
    return x;
}
__device__ __forceinline__ float row16_max(float x) {
    x = fmaxf(x, dppf<0xB1>(x)); x = fmaxf(x, dppf<0x4E>(x)); x = fmaxf(x, dppf<0x141>(x)); x = fmaxf(x, dppf<0x140>(x));
    return x;
}
__device__ __forceinline__ float rdl(float x, int l) { return __builtin_bit_cast(float, __builtin_amdgcn_readlane(__builtin_bit_cast(int, x), l)); }
__device__ __forceinline__ float wave_sum(float v) { v = row16_sum(v); return (rdl(v, 0) + rdl(v, 16)) + (rdl(v, 32) + rdl(v, 48)); }
__device__ __forceinline__ float wave_max(float v) { v = row16_max(v); return fmaxf(fmaxf(rdl(v, 0), rdl(v, 16)), fmaxf(rdl(v, 32), rdl(v, 48))); }
__device__ __forceinline__ float oct_sum(float x) { x += dppf<0xB1>(x); x += dppf<0x4E>(x); x += dppf<0x141>(x); return x; }
__device__ __forceinline__ float oct_max(float x) { x = fmaxf(x, dppf<0xB1>(x)); x = fmaxf(x, dppf<0x4E>(x)); x = fmaxf(x, dppf<0x141>(x)); return x; }
__device__ __forceinline__ int oct_min(int x) {
    x = min(x, __builtin_amdgcn_update_dpp(0, x, 0xB1, 0xf, 0xf, true)); x = min(x, __builtin_amdgcn_update_dpp(0, x, 0x4E, 0xf, 0xf, true)); x = min(x, __builtin_amdgcn_update_dpp(0, x, 0x141, 0xf, 0xf, true));
    return x;
}

__device__ __forceinline__ float fmul_s(float a, float b) { float r; asm("v_mul_f32_e32 %0, %1, %2" : "=v"(r) : "v"(a), "v"(b)); return r; }
__device__ __forceinline__ float ffma_s(float a, float b, float c) { asm("v_fmac_f32_e32 %0, %1, %2" : "+v"(c) : "v"(a), "v"(b)); return c; }
__device__ __forceinline__ void row16_sum2(float& a, float& b) {
    asm("s_nop 1\n\t"
        "v_add_f32_dpp %0, %0, %0 quad_perm:[1,0,3,2] row_mask:0xf bank_mask:0xf bound_ctrl:1\n\t"
        "v_add_f32_dpp %1, %1, %1 quad_perm:[1,0,3,2] row_mask:0xf bank_mask:0xf bound_ctrl:1\n\t"
        "s_nop 0\n\t"
        "v_add_f32_dpp %0, %0, %0 quad_perm:[2,3,0,1] row_mask:0xf bank_mask:0xf bound_ctrl:1\n\t"
        "v_add_f32_dpp %1, %1, %1 quad_perm:[2,3,0,1] row_mask:0xf bank_mask:0xf bound_ctrl:1\n\t"
        "s_nop 0\n\t"
        "v_add_f32_dpp %0, %0, %0 row_half_mirror row_mask:0xf bank_mask:0xf bound_ctrl:1\n\t"
        "v_add_f32_dpp %1, %1, %1 row_half_mirror row_mask:0xf bank_mask:0xf bound_ctrl:1\n\t"
        "s_nop 0\n\t"
        "v_add_f32_dpp %0, %0, %0 row_mirror row_mask:0xf bank_mask:0xf bound_ctrl:1\n\t"
        "v_add_f32_dpp %1, %1, %1 row_mirror row_mask:0xf bank_mask:0xf bound_ctrl:1\n\t"
        "s_nop 0"
        : "+v"(a), "+v"(b));
}

namespace pg8 {
constexpr int BM = 256, BK = 64, HALF = 128, HTB = HALF * BK * 2, STAGE_BYTES = 8 * HTB, NXCD = 8, WGM = 8;
__host__ __device__ __forceinline__ int lds_byte(int r, int c) { const int st = (r >> 4) * 2 + (c >> 5), rr = r & 15, cc = c & 31, ob = rr * 64 + cc * 2; return st * 1024 + (ob ^ (((ob >> 9) & 1) << 5)); }
__host__ __device__ __forceinline__ void stage_rc(int b, int& R, int& C) { const int st = b / 1024, sb = b % 1024, swz = sb ^ (((sb >> 9) & 1) << 5); R = (st >> 1) * 16 + swz / 64; C = (st & 1) * 32 + (swz % 64) / 2; }
__host__ __device__ __forceinline__ int perm32(int rho) { const int n = rho >> 4, i = rho & 15; return 8 * (i >> 2) + 4 * n + (i & 3); }

struct Unit { int arow, brow, gofs, nvalid, orow, pn; };
struct Gemm { const bf16_t* A; const bf16_t* Bt; const int* gidx; int lda; int K; };

struct StaticOrder {
    int nM, nN, nwg, G, c;
    __device__ void init(int M, int N, int G_, int c_) { nM = M / BM; nN = N / BM; nwg = nM * nN; G = G_; c = c_; }
    __device__ bool next(int i, Unit& u) const {
        const long L = (long)i * G + c; if (L >= nwg) return false;
        int wgid = (int)L; { const int q = nwg / NXCD, r = nwg % NXCD, xcd = wgid % NXCD, off = wgid / NXCD; wgid = (xcd < r ? xcd * (q + 1) : r * (q + 1) + (xcd - r) * q) + off; }
        const int nig = WGM * nN, gid = wgid / nig, fm = gid * WGM, gsz = (nM - fm) < WGM ? (nM - fm) : WGM;
        const int pm = fm + ((wgid % nig) % gsz), pn = (wgid % nig) / gsz;
        u.arow = pm * BM; u.brow = pn * BM; u.gofs = 0; u.nvalid = BM; u.orow = pm * BM; u.pn = pn; return true;
    }
};
struct InProjOrder {
    StaticOrder lat; int G, c;
    __device__ void init(int G_, int c_) { lat.init(NT, N_IN, G_, c_); G = G_; c = c_; }
    __device__ bool next(int i, Unit& u) const {
        const int L = i * G + c, nlat = (NT / BM) * (N_IN / BM);
        if (L < nlat) return lat.next(i, u);
        const int Lc = L - nlat; if (Lc >= 16 * 11) return false;
        const int pm = NT / BM + Lc / 11, q = Lc % 11, pn = q < 5 ? q + 2 : q + 5;
        u.arow = pm * BM; u.brow = pn * BM; u.gofs = 0; u.nvalid = BM; u.orow = pm * BM; u.pn = pn; return true;
    }
};
struct ListOrder {
    const LAS int* ul; int n;
    __device__ bool next(int i, Unit& u) const {
        if (i >= n) return false;
        const LAS int* p = ul + i * 8;
        u.arow = p[0]; u.brow = p[1]; u.gofs = p[2]; u.nvalid = p[3]; u.orow = p[4]; u.pn = p[5]; return true;
    }
};

typedef double dbl2 __attribute__((ext_vector_type(2)));
__device__ __forceinline__ unsigned cvt_pk_bf16(float lo, float hi) { unsigned r; asm volatile("v_cvt_pk_bf16_f32 %0, %1, %2" : "=v"(r) : "v"(lo), "v"(hi)); return r; }

template <class Epi, class Sched, bool GATHER, bool ALIGN_EPI>
__device__ __forceinline__ void gemm_phase(LAS unsigned char* lds, const Gemm g, const Sched& S, const Epi& E, const int tid) {
    const int wid = __builtin_amdgcn_readfirstlane(tid >> 6), lane = tid & 63, wr = wid >> 2, wc = wid & 3, fr = lane & 15, fq = lane >> 4;
    const int K = g.K, nt = K / BK, lda = g.lda;
    int sR[2], sC[2]; unsigned voffB[2];
#pragma unroll
    for (int i = 0; i < 2; ++i) { int R, C; stage_rc(tid * 16 + i * 8192, R, C); const int p32 = perm32(R & 31); const int Rb = Epi::PERM ? (64 * (R >> 5) + 16 * (p32 >> 3) + (p32 & 7)) : R; sR[i] = R; sC[i] = C; voffB[i] = (unsigned)(Rb * K + C) * 2u; }
    const size_t kstep = (size_t)(BK * 2);
    const size_t hstepB = (size_t)(Epi::PERM ? 8 : HALF) * K * 2;
    const unsigned ldsw = (unsigned)wid * 1024u;
    const int aoff = lds_byte(wr * 64 + fr, fq * 8), boff = lds_byte(wc * 32 + fr, fq * 8);
#define PG8_SA(b, h) (((b) * 2 + (h)) * HTB)
#define PG8_SB(b, h) ((4 + (b) * 2 + (h)) * HTB)
#define PG8_STAGE(bufoff, gbase, v0, v1) do { const char* gb_ = (const char*)(gbase); unsigned o0_ = (v0), o1_ = (v1); asm volatile("" : "+s"(gb_), "+v"(o0_), "+v"(o1_)); \
        __builtin_amdgcn_global_load_lds((const unsigned*)(gb_ + o0_), (LAS unsigned*)(lds + (bufoff) + ldsw), 16, 0, 0); \
        __builtin_amdgcn_global_load_lds((const unsigned*)(gb_ + o1_), (LAS unsigned*)(lds + (bufoff) + ldsw + 8192), 16, 0, 0); } while (0)
#define PG8_LDA(dst, b, h) do { _Pragma("unroll") for (int m = 0; m < 4; ++m) _Pragma("unroll") for (int k = 0; k < 2; ++k) dst[m][k] = *(const LAS bf16x8*)(lds + PG8_SA(b, h) + aoff + m * 2048 + k * 1024); } while (0)
#define PG8_LDB(dst, b, h) do { _Pragma("unroll") for (int n = 0; n < 2; ++n) _Pragma("unroll") for (int k = 0; k < 2; ++k) dst[n][k] = *(const LAS bf16x8*)(lds + PG8_SB(b, h) + boff + n * 2048 + k * 1024); } while (0)
#define PG8_MMA(ai, bj, At, Bt) do { __builtin_amdgcn_s_setprio(1); _Pragma("unroll") for (int m = 0; m < 4; ++m) _Pragma("unroll") for (int n = 0; n < 2; ++n) _Pragma("unroll") for (int k = 0; k < 2; ++k) \
        acc[ai][bj][m][n] = __builtin_amdgcn_mfma_f32_16x16x32_bf16(Bt[n][k], At[m][k], acc[ai][bj][m][n], 0, 0, 0); __builtin_amdgcn_s_setprio(0); } while (0)
#define PG8_WAIT_V(n) asm volatile("s_waitcnt vmcnt(" #n ")" ::: "memory")
#define PG8_WAIT_L(n) asm volatile("s_waitcnt lgkmcnt(" #n ")" ::: "memory")
#define PG8_BAR __builtin_amdgcn_s_barrier()
#define PG8_SCHED __builtin_amdgcn_sched_barrier(0)
#define PG8_AOFFS(u, v00, v01, v10, v11) do { int r_[4] = {sR[0], sR[1], 128 + sR[0], 128 + sR[1]}; unsigned o_[4]; _Pragma("unroll") for (int q_ = 0; q_ < 4; ++q_) { int row_; \
        if (GATHER) row_ = (r_[q_] < (u).nvalid) ? ((u).gofs >= 0 ? g.gidx[(u).gofs + r_[q_]] : (u).arow + r_[q_]) : 0; else row_ = (u).arow + r_[q_]; \
        o_[q_] = (unsigned)(row_ * lda + sC[q_ & 1]) * 2u; } v00 = o_[0]; v01 = o_[1]; v10 = o_[2]; v11 = o_[3]; } while (0)
#define PG8_STAGE_A(bufoff, ptr, h) do { if constexpr (GATHER) { if (h) PG8_STAGE(bufoff, ptr, c10, c11); else PG8_STAGE(bufoff, ptr, c00, c01); } \
        else { PG8_STAGE(bufoff, (ptr) + (h) * hstepA, voffA0, voffA1); } } while (0)
    Unit cur, nxt; int ui = 0;
    if (!S.next(0, cur)) return;
    f32x4 acc[2][2][4][2];
#define PG8_ZERO() do { _Pragma("unroll") for (int a = 0; a < 2; ++a) _Pragma("unroll") for (int b = 0; b < 2; ++b) _Pragma("unroll") for (int m = 0; m < 4; ++m) _Pragma("unroll") for (int n = 0; n < 2; ++n) { \
        dbl2 z_; double z0_, z1_; asm volatile("v_mov_b64 %0, 0" : "=v"(z0_)); asm volatile("v_mov_b64 %0, 0" : "=v"(z1_)); z_.x = z0_; z_.y = z1_; acc[a][b][m][n] = __builtin_bit_cast(f32x4, z_); } } while (0)
    PG8_ZERO();
    bf16x8 At[4][2], B0[2][2], B1[2][2];
    const size_t hstepA = (size_t)HALF * lda * 2;
    const unsigned voffA0 = (unsigned)(sR[0] * lda + sC[0]) * 2u, voffA1 = (unsigned)(sR[1] * lda + sC[1]) * 2u;
    unsigned c00 = 0, c01 = 0, c10 = 0, c11 = 0, n00 = 0, n01 = 0, n10 = 0, n11 = 0;
    if constexpr (GATHER) { PG8_AOFFS(cur, c00, c01, c10, c11); }
    const char* gA = (const char*)g.A;
    const char* cA = GATHER ? gA : gA + (size_t)cur.arow * lda * 2;
    const char* cB = (const char*)g.Bt + (size_t)cur.brow * K * 2;
    PG8_STAGE(PG8_SB(0, 0), cB, voffB[0], voffB[1]); PG8_STAGE(PG8_SB(0, 1), cB + hstepB, voffB[0], voffB[1]); PG8_STAGE_A(PG8_SA(0, 0), cA, 0); PG8_STAGE_A(PG8_SA(0, 1), cA, 1);
    if (wr == 1) PG8_BAR;
    PG8_WAIT_V(2); PG8_BAR;
    PG8_STAGE(PG8_SB(1, 0), cB + kstep, voffB[0], voffB[1]); PG8_STAGE_A(PG8_SA(1, 0), cA + kstep, 0); PG8_STAGE(PG8_SB(1, 1), cB + hstepB + kstep, voffB[0], voffB[1]);
    PG8_WAIT_V(6); PG8_BAR;
    for (;;) {
        const bool has_next = S.next(ui + 1, nxt);
        if constexpr (GATHER) { if (has_next) { PG8_AOFFS(nxt, n00, n01, n10, n11); } else { n00 = c00; n01 = c01; n10 = c10; n11 = c11; } }
        const char* nA = (GATHER || !has_next) ? cA : gA + (size_t)nxt.arow * lda * 2;
        const char* nB = has_next ? (const char*)g.Bt + (size_t)nxt.brow * K * 2 : cB;
#pragma unroll 1
        for (int t = 0; t < nt; t += 2) {
            const bool last = (t == nt - 2);
            const char* a1 = cA + (size_t)(t + 1) * kstep;
            const char* b2 = last ? nB : cB + (size_t)(t + 2) * kstep;
            const char* b3 = b2 + kstep;
            PG8_LDB(B0, 0, 0); PG8_LDB(B1, 0, 1); PG8_SCHED; PG8_LDA(At, 0, 0); PG8_STAGE_A(PG8_SA(1, 1), a1, 1);
            PG8_WAIT_V(8); PG8_WAIT_L(0); PG8_BAR; PG8_MMA(0, 0, At, B0); PG8_MMA(0, 1, At, B1); PG8_BAR; PG8_SCHED;
            if constexpr (GATHER) { if (last) { c00 = n00; c01 = n01; c10 = n10; c11 = n11; } }
            const char* a2 = last ? nA : cA + (size_t)(t + 2) * kstep;
            const char* a3 = a2 + kstep;
            PG8_LDA(At, 0, 1); PG8_STAGE(PG8_SB(0, 0), b2, voffB[0], voffB[1]); PG8_STAGE(PG8_SB(0, 1), b2 + hstepB, voffB[0], voffB[1]); PG8_STAGE_A(PG8_SA(0, 0), a2, 0);
            PG8_WAIT_V(8); PG8_WAIT_L(0); PG8_BAR; PG8_MMA(1, 0, At, B0); PG8_MMA(1, 1, At, B1); PG8_BAR; PG8_SCHED;
            PG8_LDB(B0, 1, 0); PG8_LDB(B1, 1, 1); PG8_SCHED; PG8_LDA(At, 1, 0); PG8_STAGE_A(PG8_SA(0, 1), a2, 1);
            PG8_WAIT_V(8); PG8_WAIT_L(0); PG8_BAR; PG8_MMA(0, 0, At, B0); PG8_MMA(0, 1, At, B1); PG8_BAR; PG8_SCHED;
            PG8_LDA(At, 1, 1); PG8_STAGE(PG8_SB(1, 0), b3, voffB[0], voffB[1]); PG8_STAGE(PG8_SB(1, 1), b3 + hstepB, voffB[0], voffB[1]); PG8_STAGE_A(PG8_SA(1, 0), a3, 0);
            PG8_WAIT_V(8); PG8_WAIT_L(0); PG8_BAR; PG8_MMA(1, 0, At, B0);
            if constexpr (Epi::SPLIT) { if (last) { PG8_SCHED; E(acc, cur, wr, wc, fr, fq, 0, 1); PG8_SCHED; } }
            PG8_MMA(1, 1, At, B1); PG8_BAR; PG8_SCHED;
        }
        if constexpr (ALIGN_EPI) { if (wr == 0) PG8_BAR; }
        E(acc, cur, wr, wc, fr, fq, Epi::SPLIT ? 1 : 0, 2);
        if (!has_next) break;
        PG8_ZERO();
        cur = nxt; cA = nA; cB = nB; ++ui;
        if constexpr (ALIGN_EPI) { if (wr == 1) PG8_BAR; }
    }
    PG8_WAIT_V(0);
    if constexpr (!ALIGN_EPI) { if (wr == 0) PG8_BAR; }
    PG8_BAR;
#undef PG8_STAGE_A
#undef PG8_SA
#undef PG8_SB
#undef PG8_STAGE
#undef PG8_LDA
#undef PG8_LDB
#undef PG8_MMA
#undef PG8_WAIT_V
#undef PG8_WAIT_L
#undef PG8_BAR
#undef PG8_SCHED
#undef PG8_AOFFS
#undef PG8_ZERO
}

struct EpiCols {
    static constexpr bool PERM = true, SPLIT = true;
    GAS bf16_t* crw; GAS bf16_t* chg;
    __device__ __forceinline__ void operator()(const f32x4 (&acc)[2][2][4][2], const Unit& u, int wr, int wc, int fr, int fq, const int a0, const int a1) const {
        GAS bf16_t* base; int ldc, colt;
        if (u.pn < 8) { base = crw; ldc = LD_RW; colt = u.pn * 256; } else { base = chg; ldc = LD_HG; colt = (u.pn - 8) * 256; }
        const int row0 = u.orow + wr * 64 + fr, col0 = colt + wc * 64 + 16 * fq;
#pragma unroll
        for (int ai = a0; ai < a1; ++ai)
#pragma unroll
            for (int m = 0; m < 4; ++m) { GAS bf16_t* rowp = base + (size_t)(row0 + ai * HALF + m * 16) * ldc + col0;
#pragma unroll
                for (int bj = 0; bj < 2; ++bj) { f32x4 v0 = acc[ai][bj][m][0], v1 = acc[ai][bj][m][1];
                    if (u.pn == 6 && wc < 2) {
#pragma unroll
                        for (int e = 0; e < 4; ++e) { v0[e] = ftanh(v0[e]); v1[e] = ftanh(v1[e]); } }
                    u32x4 w; w.x = cvt_pk_bf16(v0[0], v0[1]); w.y = cvt_pk_bf16(v0[2], v0[3]); w.z = cvt_pk_bf16(v1[0], v1[1]); w.w = cvt_pk_bf16(v1[2], v1[3]);
                    *(GAS u32x4*)(rowp + bj * 8) = w; } }
    }
};
struct EpiFp8 {
    static constexpr bool PERM = true, SPLIT = true;
    GAS unsigned char* O;
    __device__ __forceinline__ void operator()(const f32x4 (&acc)[2][2][4][2], const Unit& u, int wr, int wc, int fr, int fq, const int a0, const int a1) const {
        const int row0 = u.orow + wr * 64 + fr, col0 = u.pn * 256 + wc * 64 + 16 * fq;
#pragma unroll
        for (int ai = a0; ai < a1; ++ai)
#pragma unroll
            for (int m = 0; m < 4; ++m) { GAS unsigned char* rowp = O + (size_t)(row0 + ai * HALF + m * 16) * 1024 + col0;
                u32x4 w;
#pragma unroll
                for (int bj = 0; bj < 2; ++bj) { const f32x4 v0 = acc[ai][bj][m][0], v1 = acc[ai][bj][m][1];
                    int w0 = __builtin_amdgcn_cvt_pk_fp8_f32(v0[0], v0[1], 0, false); w0 = __builtin_amdgcn_cvt_pk_fp8_f32(v0[2], v0[3], w0, true);
                    int w1 = __builtin_amdgcn_cvt_pk_fp8_f32(v1[0], v1[1], 0, false); w1 = __builtin_amdgcn_cvt_pk_fp8_f32(v1[2], v1[3], w1, true);
                    if (bj == 0) { w.x = (unsigned)w0; w.y = (unsigned)w1; } else { w.z = (unsigned)w0; w.w = (unsigned)w1; } }
                *(GAS u32x4*)rowp = w; }
    }
};
struct EpiSwiglu {
    static constexpr bool PERM = true, SPLIT = true;
    GAS bf16_t* O;
    __device__ __forceinline__ void operator()(const f32x4 (&acc)[2][2][4][2], const Unit& u, int wr, int wc, int fr, int fq, const int a0, const int a1) const {
        const int row0 = u.orow + wr * 64 + fr, col0 = u.pn * 128 + wc * 32 + 8 * fq;
#pragma unroll
        for (int ai = a0; ai < a1; ++ai)
#pragma unroll
            for (int m = 0; m < 4; ++m) { GAS bf16_t* rowp = O + (size_t)(row0 + ai * HALF + m * 16) * 256 + col0;
                u32x4 w;
#pragma unroll
                for (int bj = 0; bj < 2; ++bj) { const f32x4 v0 = acc[ai][bj][m][0], v1 = acc[ai][bj][m][1];
                    const float a0 = fsilu(v0[0]) * v0[1], a1 = fsilu(v0[2]) * v0[3], a2 = fsilu(v1[0]) * v1[1], a3 = fsilu(v1[2]) * v1[3];
                    if (bj == 0) { w.x = cvt_pk_bf16(a0, a1); w.y = cvt_pk_bf16(a2, a3); } else { w.z = cvt_pk_bf16(a0, a1); w.w = cvt_pk_bf16(a2, a3); } }
                *(GAS u32x4*)rowp = w; }
    }
};
struct EpiX1 {
    static constexpr bool PERM = true, SPLIT = false;
    gcf x; gcf modf; GAS bf16_t* out;
    __device__ __forceinline__ void operator()(const f32x4 (&acc)[2][2][4][2], const Unit& u, int wr, int wc, int fr, int fq, const int a0, const int a1) const {
        const int row0 = u.orow + wr * 64 + fr, col0 = u.pn * 256 + wc * 64 + 16 * fq;
        gcf g1 = modf + (size_t)(u.orow >> 11) * NMOD + 2 * DM + col0;
        f32x4 gv[2][2];
#pragma unroll
        for (int bj = 0; bj < 2; ++bj)
#pragma unroll
            for (int n = 0; n < 2; ++n) gv[bj][n] = *(const GAS f32x4*)(g1 + bj * 8 + 4 * n);
#pragma unroll
        for (int ai = a0; ai < a1; ++ai) {
            f32x4 xv[4][2][2];
#pragma unroll
            for (int m = 0; m < 4; ++m) { const size_t off = (size_t)(row0 + ai * HALF + m * 16) * DM + col0;
#pragma unroll
                for (int bj = 0; bj < 2; ++bj) { xv[m][bj][0] = *(const GAS f32x4*)(x + off + bj * 8); xv[m][bj][1] = *(const GAS f32x4*)(x + off + bj * 8 + 4); } }
            __builtin_amdgcn_sched_barrier(0);
#pragma unroll
            for (int m = 0; m < 4; ++m) { const size_t off = (size_t)(row0 + ai * HALF + m * 16) * DM + col0;
#pragma unroll
                for (int bj = 0; bj < 2; ++bj) {
                    const f32x4 v0 = xv[m][bj][0] + gv[bj][0] * acc[ai][bj][m][0], v1 = xv[m][bj][1] + gv[bj][1] * acc[ai][bj][m][1];
                    u32x4 w; w.x = cvt_pk_bf16(v0[0], v0[1]); w.y = cvt_pk_bf16(v0[2], v0[3]); w.z = cvt_pk_bf16(v1[0], v1[1]); w.w = cvt_pk_bf16(v1[2], v1[3]);
                    *(GAS u32x4*)(out + off + bj * 8) = w; } }
            __builtin_amdgcn_sched_barrier(0);
        }
    }
};
}

#define XB_TMO      128
#define XB_XCNT(j)  (256  + 64 * (j))
#define XB_XSUB(j)  (1280 + 64 * (j))
#define XB_XGEN(j)  (2304 + 64 * (j))
#define XB_TOP      3328
#define XB_TOPGEN   3392
#define XCD_BAR_WORDS 3456
#define XB_SPIN_CAP (1u << 22)
__device__ __forceinline__ unsigned xb_ld(unsigned* p)              { return __hip_atomic_load(p, __ATOMIC_RELAXED, __HIP_MEMORY_SCOPE_AGENT); }
__device__ __forceinline__ unsigned xb_add(unsigned* p, unsigned v) { return __hip_atomic_fetch_add(p, v, __ATOMIC_RELAXED, __HIP_MEMORY_SCOPE_AGENT); }
__device__ __forceinline__ unsigned xb_xcc_id() { return (unsigned)__builtin_amdgcn_s_getreg((3 << 11) | 20) & 0xFu; }
#define XB_SPIN(cond, bar) do { unsigned _sp = 0; while (cond) { __builtin_amdgcn_s_sleep(1); \
    if ((++_sp & 255u) == 0u) { if (xb_ld(&(bar)[XB_TMO])) break; if (_sp > XB_SPIN_CAP) { atomicAdd(&(bar)[XB_TMO], 1u); break; } } } } while (0)
struct XcdBarrier { unsigned* bar; unsigned x; volatile LAS unsigned* st; };
__device__ __forceinline__ XcdBarrier xcd_barrier_post(unsigned* bar, volatile LAS unsigned* st) {
    XcdBarrier b; b.bar = bar; b.x = xb_xcc_id(); b.st = st;
    if (threadIdx.x == 0) (void)xb_add(&bar[XB_XCNT(b.x)], 1u);
    return b;
}
__device__ __forceinline__ void xcd_barrier_complete(unsigned* bar, unsigned x, unsigned& nloc, unsigned& nx) {
    const unsigned G = gridDim.x * gridDim.y * gridDim.z;
    unsigned sum, cnt, mine, sp = 0u;
    for (;;) {
        sum = 0u; cnt = 0u; mine = 0u;
#pragma unroll 1
        for (unsigned j = 0; j < 16; ++j) { const unsigned c = xb_ld(&bar[XB_XCNT(j)]); sum += c; cnt += (c > 0u) ? 1u : 0u; mine = (j == x) ? c : mine; }
        if (sum == G) break;
        __builtin_amdgcn_s_sleep(1);
        if ((++sp & 255u) == 0u) { if (xb_ld(&bar[XB_TMO])) break; if (sp > XB_SPIN_CAP) { atomicAdd(&bar[XB_TMO], 1u); break; } }
    }
    nloc = mine > 0u ? mine : 1u; nx = cnt > 0u ? cnt : 1u;
}
__device__ __forceinline__ void xcd_barrier(const XcdBarrier& b) {
    asm volatile("s_waitcnt vmcnt(0)" ::: "memory");
    __syncthreads();
    if (threadIdx.x == 0) {
        unsigned* bar = b.bar;
        __builtin_amdgcn_s_waitcnt(0);
        unsigned nloc = b.st[0], nx = b.st[1];
        if (nloc == 0u) { xcd_barrier_complete(bar, b.x, nloc, nx); b.st[0] = nloc; b.st[1] = nx; }
        const unsigned old = xb_add(&bar[XB_XSUB(b.x)], 1u);
        const unsigned gen = old / nloc;
        if (old + 1u == (gen + 1u) * nloc) {
            __builtin_amdgcn_fence(__ATOMIC_RELEASE, "agent");
            asm volatile("s_waitcnt vmcnt(0)" ::: "memory");
            const unsigned og = xb_add(&bar[XB_TOP], 1u);
            const unsigned tg = og / nx;
            if (og + 1u == (tg + 1u) * nx) xb_add(&bar[XB_TOPGEN], 1u);
            else XB_SPIN(xb_ld(&bar[XB_TOPGEN]) == tg, bar);
            __builtin_amdgcn_fence(__ATOMIC_ACQUIRE, "agent");
            xb_add(&bar[XB_XGEN(b.x)], 1u);
            asm volatile("s_waitcnt vmcnt(0)" ::: "memory");
        } else {
            XB_SPIN(xb_ld(&bar[XB_XGEN(b.x)]) == gen, bar);
            __builtin_amdgcn_fence(__ATOMIC_ACQUIRE, "agent");
            asm volatile("s_waitcnt vmcnt(0)" ::: "memory");
        }
    }
    __syncthreads();
}

struct Frame {
    LAS unsigned char* lds;
    volatile LAS unsigned* MISC;
    gu32* ctl;
    int tid, lane, wave, bid, G, dup;
    const gcf __attribute__((address_space(4)))* inp;
    float* out; unsigned char* ws;
};
#define LAUNDER(F) do { asm volatile("" : "+s"((F).ws), "+s"((F).out), "+s"((F).inp)); } while (0)
enum { I_X = 0, I_C, I_CTX, I_CCTX, I_WMOD, I_BMOD, I_N1G, I_N2G, I_WIN, I_CONV, I_W0, I_W2, I_A0, I_A2, I_G2, I_KK, I_KA, I_RK, I_LNG, I_LNB, I_LB, I_HGN, I_WOUT, I_RW, I_RB, I_EG, I_EU, I_ED, I_SG, I_SU, I_SD, I_FNG };

template <bool P2 = false> __device__ __forceinline__ void tr_load(gcf W, int N, int item, int lane, f32x4 (&tv)[8]) {
    const int nblk = N / 32, lnb = __builtin_ctz(nblk), kb = P2 ? item >> lnb : item / nblk, nb = P2 ? item & (nblk - 1) : item % nblk, k0 = 64 * kb, n0 = 32 * nb;
    const GAS float* p = W + (size_t)(k0 + 2 * (lane >> 3)) * N + n0 + 4 * (lane & 7);
#pragma unroll
    for (int i = 0; i < 4; ++i) { tv[2 * i] = *(const GAS f32x4*)(p + (size_t)(16 * i) * N); tv[2 * i + 1] = *(const GAS f32x4*)(p + (size_t)(16 * i + 1) * N); }
}
template <bool P2 = false> __device__ __forceinline__ void tr_finish(const f32x4 (&tv)[8], int K, int N, bf16_t* WT, int row_mul, int row_add, LAS float* scr, int item, int lane) {
    const int nblk = N / 32, lnb = __builtin_ctz(nblk), kb = P2 ? item >> lnb : item / nblk, nb = P2 ? item & (nblk - 1) : item % nblk, k0 = 64 * kb, n0 = 32 * nb;
    LAS unsigned* T = (LAS unsigned*)scr;
    const int kq = lane >> 3, nq = lane & 7;
#pragma unroll
    for (int i = 0; i < 4; ++i)
#pragma unroll
        for (int j = 0; j < 4; ++j) T[(4 * nq + j) * 34 + 8 * i + kq] = cvtpk(tv[2 * i][j], tv[2 * i + 1][j]);
    LDS_WAIT(); asm volatile("" ::: "memory");
    const int c = lane & 7;
#pragma unroll
    for (int j = 0; j < 4; ++j) { const int n = (lane >> 3) + 8 * j; const LAS unsigned* sp = T + n * 34 + 4 * c;
        const u32x2 a = *(const LAS u32x2*)sp, b2 = *(const LAS u32x2*)(sp + 2);
        *(GAS u32x4*)(WT + (size_t)((n0 + n) * row_mul + row_add) * K + k0 + 8 * c) = (u32x4){a.x, a.y, b2.x, b2.y}; }
    LDS_WAIT(); asm volatile("" ::: "memory");
}
__device__ __forceinline__ void p0_transpose_item(gcf W, int K, int N, bf16_t* WT, int row_mul, int row_add, LAS float* scr, int item, int lane) {
    f32x4 tv[8]; tr_load(W, N, item, lane, tv); tr_finish(tv, K, N, WT, row_mul, row_add, scr, item, lane);
}
constexpr int NEXP_ITEMS = 65 * 384;
struct ExpItem { gcf W; bf16_t* WT; int K, N, row_mul, row_add, sub; };
__device__ __forceinline__ ExpItem exp_item(Frame& F, int idx) {
    const int e = idx / 384, q = idx % 384, which = q >> 7, sub = q & 127;
    bf16_t* W1E = (bf16_t*)(F.ws + WS_W1E); bf16_t* W2E = (bf16_t*)(F.ws + WS_W2E);
    gcf pEG = F.inp[I_EG], pEU = F.inp[I_EU], pED = F.inp[I_ED], pSG = F.inp[I_SG], pSU = F.inp[I_SU], pSD = F.inp[I_SD];
    asm volatile("" : "+s"(pEG), "+s"(pEU), "+s"(pED), "+s"(pSG), "+s"(pSU), "+s"(pSD));
    ExpItem it;
    if (which == 0) { it.W = e < 64 ? pEG + (size_t)e * DM * 256 : pSG; it.WT = W1E + (size_t)e * 512 * DM; it.K = DM; it.N = 256; it.row_mul = 2; it.row_add = 0; }
    else if (which == 1) { it.W = e < 64 ? pEU + (size_t)e * DM * 256 : pSU; it.WT = W1E + (size_t)e * 512 * DM; it.K = DM; it.N = 256; it.row_mul = 2; it.row_add = 1; }
    else { it.W = e < 64 ? pED + (size_t)e * 256 * DM : pSD; it.WT = W2E + (size_t)e * DM * 256; it.K = 256; it.N = DM; it.row_mul = 1; it.row_add = 0; }
    it.sub = sub; return it;
}
__device__ __forceinline__ void p0a(Frame& F) {
    LAUNDER(F);
    LAS float* scr = (LAS float*)(F.lds + F.wave * 16384);
    const int gw = F.bid * 8 + F.wave, NGW = F.G * 8;
    unsigned char* ws = F.ws;
    bf16_t* WIN = (bf16_t*)(ws + WS_WIN); bf16_t* WOUT = (bf16_t*)(ws + WS_WOUT); bf16_t* G2T = (bf16_t*)(ws + WS_G2T);
    constexpr int I_IN = 16 * 140, I_OUT = 16 * 32, I_G2T = 2 * 16;
    constexpr int NITEMS = I_IN + I_OUT + I_G2T;
    for (int it = gw; it < NITEMS; it += NGW) {
        int r = it;
        if (r < I_IN) { const int nb = r % 140; p0_transpose_item(F.inp[I_WIN], DM, P_IN, WIN, 1, (nb * 32 >= 1920) ? 128 : 0, scr, r, F.lane); continue; } r -= I_IN;
        if (r < I_OUT) { p0_transpose_item(F.inp[I_WOUT], DM, DM, WOUT, 1, 0, scr, r, F.lane); continue; } r -= I_OUT;
        p0_transpose_item(F.inp[I_G2], 128, 512, G2T, 1, 0, scr, r, F.lane);
    }
    { const int gt = F.bid * 512 + F.tid; unsigned zu = 0u; asm volatile("" : "+v"(zu)); if (gt < 128 * 1024 / 8) *(GAS u32x4*)(WIN + (size_t)1920 * DM + (size_t)gt * 8) = (u32x4){zu, zu, zu, zu}; }
    { bf16_t* RWT = (bf16_t*)(ws + WS_RWT); const int gt = F.bid * 512 + F.tid; if (gt < 65536) { const int e = gt >> 10, col = gt & 1023; const float w = F.inp[I_RW][col * 64 + e]; const unsigned short hi = cvt1(w); RWT[gt] = hi; RWT[65536 + gt] = cvt1(w - bf2f(hi)); } }
    float* MODP = (float*)(ws + WS_MODP);
    for (int q = gw; q < 96 * 16; q += NGW) {
        const int cg = q % 96, ks = q / 96, col = cg * 64 + F.lane, k0 = ks * 64;
        float sv[17], acc[17];
#pragma unroll
        for (int b = 0; b < 17; ++b) { const float cv = (b < 16) ? F.inp[I_C][b * DM + k0 + F.lane] : F.inp[I_CCTX][k0 + F.lane]; sv[b] = siluf_(cv); acc[b] = 0.f; }
        gcf wp = F.inp[I_WMOD] + (size_t)k0 * NMOD + col;
#pragma unroll 8
        for (int kk = 0; kk < 64; ++kk) { const float w = wp[(size_t)kk * NMOD];
#pragma unroll
            for (int b = 0; b < 17; ++b) acc[b] += __builtin_bit_cast(float, __builtin_amdgcn_readlane(__builtin_bit_cast(int, sv[b]), kk)) * w; }
#pragma unroll
        for (int b = 0; b < 17; ++b) MODP[(size_t)(ks * 17 + b) * NMOD + col] = acc[b];
    }
}
__device__ __forceinline__ float mod_val(Frame& F, int b, int j) {
    const float* MODP = (const float*)(F.ws + WS_MODP);
    float s = F.inp[I_BMOD][j];
#pragma unroll
    for (int ks = 0; ks < 16; ++ks) s += MODP[(size_t)(ks * 17 + b) * NMOD + j];
    return s;
}
__device__ __forceinline__ void h_rows(Frame& F, gcf src, bf16_t* dst, int nrows, LAS float* gs, LAS float* sh) {
    for (int r = F.wave; r < nrows; r += 8) {
        const GAS f32x4* xr = (const GAS f32x4*)(src + (size_t)r * DM) + F.lane;
        f32x4 v[4]; float s = 0.f;
#pragma unroll
        for (int j = 0; j < 4; ++j) { v[j] = xr[64 * j]; s += (v[j].x * v[j].x + v[j].y * v[j].y) + (v[j].z * v[j].z + v[j].w * v[j].w); }
        const float rstd = 1.0f / sqrtf(wave_sum(s) * (1.f / DM) + 1e-6f);
        GAS u32x2* o8 = (GAS u32x2*)(dst + (size_t)r * DM) + F.lane;
#pragma unroll
        for (int j = 0; j < 4; ++j) { const int c = 4 * F.lane + 256 * j; const f32x4 g = *(const LAS f32x4*)(gs + c), h = *(const LAS f32x4*)(sh + c);
            u32x2 w; w.x = pk2(v[j].x * rstd * g.x + h.x, v[j].y * rstd * g.y + h.y); w.y = pk2(v[j].z * rstd * g.z + h.z, v[j].w * rstd * g.w + h.w); o8[64 * j] = w; }
    }
}
__device__ __forceinline__ void p0b(Frame& F) {
    LAUNDER(F);
    float* MODF = (float*)(F.ws + WS_MODF);
    { const int gt = F.bid * 512 + F.tid; if (gt < 17 * NMOD) MODF[gt] = mod_val(F, gt / NMOD, gt % NMOD); }
    LAS float* gs = (LAS float*)F.lds; LAS float* sh = gs + DM;
    bf16_t* H = (bf16_t*)F.out;
    const int b = F.bid >> 4;
    for (int pass = 0; pass < 2; ++pass) {
        const int mb = pass == 0 ? b : 16;
        __syncthreads();
        for (int c = F.tid; c < DM; c += 512) { gs[c] = F.inp[I_N1G][c] * (1.0f + mod_val(F, mb, DM + c)); sh[c] = mod_val(F, mb, c); }
        __syncthreads();
        if (pass == 0) { const int r0 = b * SEQ + (F.bid & 15) * 128; h_rows(F, F.inp[I_X] + (size_t)r0 * DM, H + (size_t)r0 * DM, 128, gs, sh); }
        else { const int r0 = F.bid * 16; h_rows(F, F.inp[I_CTX] + (size_t)r0 * DM, H + (size_t)(NT + r0) * DM, 16, gs, sh); }
    }
}

__device__ __forceinline__ int conv_nb(int seg, int t, int dy, int dx) {
    if (seg == 1) { const int yy = (t >> 6) + dy, xx = (t & 63) + dx; const bool ok = (yy >= 0) && (yy < 32) && (xx >= 0) && (xx < 64); return ok ? yy * 64 + xx : -1; }
    const int tt = t + dx; const bool ok = (dy == 0) && (tt >= 0) && (tt < CTXL); return ok ? tt : -1;
}
__device__ __forceinline__ void rwkv_unit(Frame& F, int b, int h, int d) {
    LAUNDER(F);
    int tle = F.tid; asm volatile("" : "+v"(tle));
    const int tid = tle, wave = F.wave;
#define RW_PTRS() unsigned char* wsl_ = F.ws; float* outl_ = F.out; asm volatile("" : "+s"(wsl_), "+s"(outl_)); \
    const GAS bf16_t* CRW = (const GAS bf16_t*)(wsl_ + WS_CRW); GAS bf16_t* YRW = (GAS bf16_t*)outl_ + (size_t)d * NT * 512; GAS bf16_t* VCONV = (GAS bf16_t*)(wsl_ + WS_VCONV); \
    GAS float* CSC = (GAS float*)(wsl_ + WS_CSC) + (size_t)d * NT * 8; const GAS unsigned char* WSB = (const GAS unsigned char*)wsl_; (void)CRW; (void)YRW; (void)VCONV; (void)CSC; (void)WSB
    constexpr unsigned ZOFF = (unsigned)WS_WIN + 1920u * DM * 2u;
    LAS float* L = (LAS float*)F.lds;
    LAS float* RC = L;
    LAS float* KT = L + 2048;
    LAS float* VC = L + 4096;
    LAS float* PW = L + 6144;
    LAS float* PA = L + 8192;
    LAS float* LY = L + 10240;
    LAS float* CW = L + 12288;
    LAS float* GT = L + 14080;
    LAS float* LGK = L + 14592;
    LAS float* PAR = L + 14656;
    LAS float* INVN = L + 14976;
    LAS float* R16 = L + 15008;
    LAS float* CSV = (LAS float*)(F.lds + 132096);
    LAS bf16_t* AH = (LAS bf16_t*)(F.lds + 61440);
    LAS bf16_t* BC = AH + 32 * 72;
    LAS bf16_t* KC = BC + 32 * 72;
    LAS bf16_t* RH = KC + 32 * 72;
    LAS bf16_t* A0 = RH + 32 * 72;
    LAS bf16_t* R0 = A0 + 32 * 72;
    LAS bf16_t* BBT = R0 + 32 * 72;
    LAS bf16_t* KBT = BBT + 64 * 40;
    LAS bf16_t* VT = KBT + 64 * 40;
    LAS bf16_t* SAT = VT + 64 * 40;
    LAS bf16_t* NLb = SAT + 64 * 40;
    for (int i = tid; i < 4096; i += 512) { const int j = i >> 6, c = i & 63; L[i] = F.inp[I_W2][(size_t)(d * 64 + j) * 512 + h * 64 + c]; L[4096 + i] = F.inp[I_A2][(size_t)(d * 64 + j) * 512 + h * 64 + c]; }
    LDS_BARRIER();
    bf16x8 bfrag[4];
    if (wave >= 2 && wave < 6) {
        const int arr = (wave - 2) >> 1, ct = (wave - 2) & 1, hh = (tid & 63) >> 5;
        const LAS float* Ws = L + arr * 4096 + ct * 32 + (tid & 31);
#pragma unroll
        for (int js = 0; js < 4; ++js) { u32x4 t;
            t.x = cvtpk(Ws[(16 * js + 8 * hh + 0) * 64], Ws[(16 * js + 8 * hh + 1) * 64]); t.y = cvtpk(Ws[(16 * js + 8 * hh + 2) * 64], Ws[(16 * js + 8 * hh + 3) * 64]);
            t.z = cvtpk(Ws[(16 * js + 8 * hh + 4) * 64], Ws[(16 * js + 8 * hh + 5) * 64]); t.w = cvtpk(Ws[(16 * js + 8 * hh + 6) * 64], Ws[(16 * js + 8 * hh + 7) * 64]);
            bfrag[js] = __builtin_bit_cast(bf16x8, t); }
    }
    LDS_BARRIER();
    for (int i = tid; i < 9 * 192; i += 512) { const int tap = i / 192, q = i % 192, which = q >> 6, c = q & 63; CW[i] = F.inp[I_CONV][tap * 1536 + which * 512 + h * 64 + c]; }
    if (tid < 64) { const int chp = h * 64 + tid;
        PAR[tid] = F.inp[I_KK][chp]; PAR[64 + tid] = F.inp[I_KA][chp]; PAR[128 + tid] = F.inp[I_RK][chp]; PAR[192 + tid] = F.inp[I_W0][d * 512 + chp]; PAR[256 + tid] = F.inp[I_A0][d * 512 + chp]; }
    LAS unsigned* MSK = (LAS unsigned*)(F.lds + 140288);
    if (tid < 192) { const int ty = tid >> 6, ln = tid & 63, r32_ = ln & 31, hh_ = ln >> 5;
#pragma unroll
        for (int m = 0; m < 8; ++m) { const int i0 = 2 * m, cr0 = (i0 & 3) + 8 * (i0 >> 2) + 4 * hh_, cr1 = cr0 + 1;
            const bool k0 = ty == 0 ? (r32_ < cr0) : (ty == 1 ? (cr0 < r32_) : (cr0 <= r32_)), k1 = ty == 0 ? (r32_ < cr1) : (ty == 1 ? (cr1 < r32_) : (cr1 <= r32_));
            MSK[(ty * 64 + ln) * 8 + m] = (k0 ? 0xffffu : 0u) | (k1 ? 0xffff0000u : 0u); } }
    LAS f32x4* SST = (LAS f32x4*)(F.lds + 114688) + wave * 512 + (tid & 63);
    if (wave < 2) {
#pragma unroll
        for (int q = 0; q < 8; ++q) SST[q * 64] = (f32x4){0.f, 0.f, 0.f, 0.f};
    }
    u32x4 tp0[9], tp1[9], lraw[4];
    const bool nostore = F.dup && DUP_MODE >= 5;
    const bool sk_mfma = F.dup && DUP_MODE == 5, sk_conv = F.dup && DUP_MODE == 6, sk_p2 = F.dup && DUP_MODE == 7, sk_p1 = F.dup && DUP_MODE == 8;
#define RW_GEOM(cgi, seg, Ls, rowbase, t0) const int seg = (cgi) < 8 ? 0 : 1, Ls = seg == 0 ? CTXL : SEQ, rowbase = seg == 0 ? NT + b * CTXL : b * SEQ, \
        t0 = d == 0 ? ((cgi) - (seg ? 8 : 0)) * TCS : Ls - 1 - ((cgi) - (seg ? 8 : 0)) * TCS
#define RW_TAPS(tp, cgi, item_) do { RW_GEOM(cgi, seg_, Ls_, rb_, t0_); (void)Ls_; const int dir_ = d == 0 ? 1 : -1; \
        const int cs_ = (item_) / 24, cg_ = (item_) % 24, t = t0_ + dir_ * cs_; const int colb = (cg_ >> 3) * 512 + h * 64 + (cg_ & 7) * 8; \
        const int y_ = t >> 6, x_ = seg_ ? (t & 63) : t, xmax_ = seg_ ? 63 : CTXL - 1; \
        const bool ym_ = seg_ && y_ > 0, yp_ = seg_ && y_ < 31, xm_ = x_ > 0, xp_ = x_ < xmax_; \
        const unsigned boff_ = (unsigned)WS_CRW + (unsigned)((rb_ + t) * LD_RW + colb) * 2u, zoff_ = ZOFF + (unsigned)colb * 2u; \
        _Pragma("unroll") for (int q = 0; q < 9; ++q) { const int dy = q / 3 - 1, dx = q % 3 - 1; \
            const bool ok = (dy == 0 || (dy < 0 ? ym_ : yp_)) && (dx == 0 || (dx < 0 ? xm_ : xp_)); \
            const unsigned off_ = ok ? boff_ + (unsigned)((dy * 64 + dx) * LD_RW * 2) : zoff_; tp[q] = *(const GAS u32x4*)(WSB + off_); } } while (0)
#define RW_TAPGEO(cgi, item_, boff_, zoff_, ym_, yp_, xm_, xp_) do { RW_GEOM(cgi, seg_, Ls_, rb_, t0_); (void)Ls_; const int dir_ = d == 0 ? 1 : -1; \
        const int cs_ = (item_) / 24, cg_ = (item_) % 24, t = t0_ + dir_ * cs_; const int colb = (cg_ >> 3) * 512 + h * 64 + (cg_ & 7) * 8; \
        const int y_ = t >> 6, x_ = seg_ ? (t & 63) : t, xmax_ = seg_ ? 63 : CTXL - 1; \
        ym_ = seg_ && y_ > 0; yp_ = seg_ && y_ < 31; xm_ = x_ > 0; xp_ = x_ < xmax_; \
        boff_ = (unsigned)WS_CRW + (unsigned)((rb_ + t) * LD_RW + colb) * 2u; zoff_ = ZOFF + (unsigned)colb * 2u; } while (0)
#define RW_TAPQ(tp, q, boff_, zoff_, ym_, yp_, xm_, xp_) do { constexpr int dy = (q) / 3 - 1, dx = (q) % 3 - 1; \
        const bool ok = (dy == 0 || (dy < 0 ? ym_ : yp_)) && (dx == 0 || (dx < 0 ? xm_ : xp_)); \
        const unsigned off_ = ok ? boff_ + (unsigned)((dy * 64 + dx) * LD_RW * 2) : zoff_; tp[q] = *(const GAS u32x4*)(WSB + off_); } while (0)
#define RW_LRAW(cgi, tq_) do { if (wave < 6) { RW_GEOM(cgi, seg_, Ls_, rb_, t0_); (void)Ls_; (void)seg_; const int dir_ = d == 0 ? 1 : -1; const int t = t0_ + dir_ * ((tq_) & 31); const GAS bf16_t* rp = CRW + (size_t)(rb_ + t) * LD_RW + (((wave - 2) >> 1) == 0 ? 1536 : 1664) + d * 64 + 8 * (((tq_) & 63) >> 5); \
          _Pragma("unroll") for (int js = 0; js < 4; ++js) lraw[js] = *(const GAS u32x4*)(rp + 16 * js); } } while (0)
#define RW_LOAD0(cgi, tq_) do { RW_TAPS(tp0, cgi, (tq_)); \
        if (wave < 6) { RW_GEOM(cgi, seg_, Ls_, rb_, t0_); (void)Ls_; (void)seg_; const int dir_ = d == 0 ? 1 : -1; const int t = t0_ + dir_ * ((tq_) & 31); const GAS bf16_t* rp = CRW + (size_t)(rb_ + t) * LD_RW + (((wave - 2) >> 1) == 0 ? 1536 : 1664) + d * 64 + 8 * (((tq_) & 63) >> 5); \
          _Pragma("unroll") for (int js = 0; js < 4; ++js) lraw[js] = *(const GAS u32x4*)(rp + 16 * js); } } while (0)
#define RW_LOAD1(cgi, tq_) RW_TAPS(tp1, cgi, (tq_) + 384)
#define RW_CONV_EPI(o, cs_, cgn2_) do { LAS float* dst = (which == 0 ? RC : (which == 1 ? KT : VC)) + (cs_) * 64 + c0; \
        *(LAS f32x4*)dst = (f32x4){o[0], o[1], o[2], o[3]}; *(LAS f32x4*)(dst + 4) = (f32x4){o[4], o[5], o[6], o[7]}; \
        if (d == 0 && which == 2) { RW_GEOM(cgn2_, sg_, Lg_, rg_, tg_); (void)Lg_;     \
            if (sg_ == 1) *(GAS u32x4*)(VCONV + (size_t)(rg_ + tg_ + (cs_)) * 512 + h * 64 + c0) = (u32x4){cvtpk(o[0], o[1]), cvtpk(o[2], o[3]), cvtpk(o[4], o[5]), cvtpk(o[6], o[7])}; } \
        { float ss_ = (o[0] * k0_.x) * (o[0] * k0_.x) + (o[1] * k0_.y) * (o[1] * k0_.y) + (o[2] * k0_.z) * (o[2] * k0_.z) + (o[3] * k0_.w) * (o[3] * k0_.w) \
                    + (o[4] * k1_.x) * (o[4] * k1_.x) + (o[5] * k1_.y) * (o[5] * k1_.y) + (o[6] * k1_.z) * (o[6] * k1_.z) + (o[7] * k1_.w) * (o[7] * k1_.w);     \
          ss_ = oct_sum(ss_); if (cgq_ == 8) INVN[(cs_)] = __builtin_amdgcn_rsqf(fmaxf(ss_, 1e-24f)); } } while (0)
#define RW_CONV2(it_, cgn2_) do { const int csa_ = (it_) / 24, cgq_ = (it_) % 24, which = cgq_ >> 3, c0 = (cgq_ & 7) * 8; float oa[8], ob[8]; \
        _Pragma("unroll") for (int e = 0; e < 8; ++e) { oa[e] = 0.f; ob[e] = 0.f; } \
        _Pragma("unroll") for (int q = 0; q < 9; ++q) { \
            const LAS float* cw = CW + q * 192 + which * 64 + c0; const f32x4 w0 = *(const LAS f32x4*)cw, w1 = *(const LAS f32x4*)(cw + 4); const u32x4 ra = tp0[q], rb2 = tp1[q]; \
            oa[0] += bflo(ra.x) * w0.x; oa[1] += bfhi(ra.x) * w0.y; oa[2] += bflo(ra.y) * w0.z; oa[3] += bfhi(ra.y) * w0.w; \
            oa[4] += bflo(ra.z) * w1.x; oa[5] += bfhi(ra.z) * w1.y; oa[6] += bflo(ra.w) * w1.z; oa[7] += bfhi(ra.w) * w1.w; \
            ob[0] += bflo(rb2.x) * w0.x; ob[1] += bfhi(rb2.x) * w0.y; ob[2] += bflo(rb2.y) * w0.z; ob[3] += bfhi(rb2.y) * w0.w; \
            ob[4] += bflo(rb2.z) * w1.x; ob[5] += bfhi(rb2.z) * w1.y; ob[6] += bflo(rb2.w) * w1.z; ob[7] += bfhi(rb2.w) * w1.w; \
            if (q % 3 == 2) asm volatile("" ::: "memory"); } \
        const f32x4 k0_ = *(const LAS f32x4*)(PAR + c0), k1_ = *(const LAS f32x4*)(PAR + c0 + 4); \
        RW_CONV_EPI(oa, csa_, cgn2_); RW_CONV_EPI(ob, csa_ + 16, cgn2_); } while (0)
#define RW_PREA(cgn_, tq_) do { RW_LOAD1(cgn_, tq_); \
        if (wave < 6) { const int arr = (wave - 2) >> 1, ct = (wave - 2) & 1, hh = ((tq_) & 63) >> 5; f32x16 acc; \
            _Pragma("unroll") for (int i = 0; i < 16; ++i) acc[i] = 0.f; \
            _Pragma("unroll") for (int js = 0; js < 4; ++js) { u32x4 raw = lraw[js]; \
                acc = __builtin_amdgcn_mfma_f32_32x32x16_bf16(__builtin_bit_cast(bf16x8, raw), bfrag[js], acc, 0, 0, 0); } \
            LAS float* dstp = (arr == 0 ? PW : PA) + ct * 32 + ((tq_) & 31); \
            _Pragma("unroll") for (int i = 0; i < 16; ++i) { const int srow = (i & 3) + 8 * (i >> 2) + 4 * hh; dstp[srow * 64] = acc[i]; } } \
        RW_CONV2((tq_), cgn_); } while (0)
    LDS_BARRIER();
    if (wave >= 2) { RW_PTRS(); const int tq = tid - 128; RW_LOAD0(0, tq); RW_PREA(0, tq); RW_TAPS(tp0, 1, tq); RW_LRAW(1, tq); }
    LDS_BARRIER();
#pragma unroll 1
    for (int cgi = 0; cgi < 72; ++cgi) {
        RW_GEOM(cgi, seg, Ls, rowbase, t0); (void)Ls;
        const int dir = d == 0 ? 1 : -1;
        int tl = tid; asm volatile("" : "+v"(tl));
        RW_PTRS();
        const int lane = tl & 63, k = lane, g4 = 4 * wave, ch = h * 64 + lane;
        float va[4], vb[4], vk[4], vr[4], vv[4], vlw[4];
        const float p_w0 = PAR[192 + lane];
        {
            const float p_kk = PAR[lane], p_ka = PAR[64 + lane], p_a0 = PAR[256 + lane], p_rk = PAR[128 + lane];
            float csv[4];
#pragma unroll
            for (int t = 0; t < 4; ++t) {
                const int p = g4 + t, idx = p * 64 + lane, tok = t0 + dir * p;
                const float kc = KT[idx], r = RC[idx], v = VC[idx], af = fsigmoid(PA[idx] + p_a0), sw = fsigmoid(PW[idx] + p_w0);
                const float kk = kc * p_kk * INVN[p];
                const float kd = kc * (1.0f + (af - 1.0f) * p_ka);
                va[t] = -kk; vb[t] = kk * af; vk[t] = kd; vr[t] = r; vv[t] = v; vlw[t] = -0.87503870f * sw;
                csv[t] = r * kd * p_rk;
            }
            if (seg == 1) {
#pragma unroll
                for (int t = 0; t < 4; ++t) CSV[(g4 + t) * 64 + lane] = csv[t];
            }
        }
        const float c0 = vlw[0], c1 = c0 + vlw[1], c2 = c1 + vlw[2], c3 = c2 + vlw[3];
        GT[wave * 64 + k] = c3;
        if (wave == 4) R16[k] = vlw[0];
        if (cgi > 8 && !nostore) {
            RW_GEOM(cgi - 1, segp, Lsp, rbp, t0p); (void)Lsp; (void)segp;
            const int s_ = tl >> 4, v0 = 4 * (tl & 15), t = t0p + dir * s_;
            const f32x4 yv = *(const LAS f32x4*)(LY + s_ * 64 + v0);
            u32x2 w; w.x = cvtpk(yv.x, yv.y); w.y = cvtpk(yv.z, yv.w);
            *(GAS u32x2*)(YRW + (size_t)(rbp + t) * 512 + h * 64 + v0) = w;
        }
        LDS_BARRIER();
        if (!sk_p2) {
            float pre = 0.f, last = 0.f, rho = 0.f;
            int wv_ = wave; asm volatile("" : "+s"(wv_));
#pragma unroll
            for (int gg = 0; gg < 8; ++gg) { const float gt = GT[gg * 64 + k]; if (gg < wv_) pre += gt; if (gg < 4) rho += gt; last += gt; }
            rho += R16[k];
            const float er = __builtin_amdgcn_exp2f(rho), eir = __builtin_amdgcn_exp2f(-rho), el = __builtin_amdgcn_exp2f(last);
            const float cum[4] = {pre + c0, pre + c1, pre + c2, pre + c3};
            float bbf[4], kbf[4];
            float ecp = __builtin_amdgcn_exp2f(pre);
#pragma unroll
            for (int t = 0; t < 4; ++t) {
                const int p = g4 + t;
                const float ec = __builtin_amdgcn_exp2f(cum[t]), eic = __builtin_amdgcn_exp2f(-cum[t]), ecx = ecp; ecp = ec;
                AH[p * 72 + k] = cvt1(va[t] * ecx * eir); BC[p * 72 + k] = cvt1(vb[t] * er * eic); KC[p * 72 + k] = cvt1(vk[t] * er * eic); RH[p * 72 + k] = cvt1(vr[t] * ec * eir);
                A0[p * 72 + k] = cvt1(va[t] * ecx); R0[p * 72 + k] = cvt1(vr[t] * ec);
                bbf[t] = vb[t] * el * eic; kbf[t] = vk[t] * el * eic;
            }
            *(LAS u32x2*)(BBT + k * 40 + g4) = (u32x2){cvtpk(bbf[0], bbf[1]), cvtpk(bbf[2], bbf[3])};
            *(LAS u32x2*)(KBT + k * 40 + g4) = (u32x2){cvtpk(kbf[0], kbf[1]), cvtpk(kbf[2], kbf[3])};
            *(LAS u32x2*)(VT + k * 40 + g4) = (u32x2){cvtpk(vv[0], vv[1]), cvtpk(vv[2], vv[3])};
            if (wave == 0) LGK[k] = el;
        }
        LDS_BARRIER();
        if (wave < 2 && !sk_mfma) {
            const int vt = wave, r32 = lane & 31, hh = lane >> 5;
            (void)NLb;
            f32x16 S0, S1;
#pragma unroll
            for (int q = 0; q < 4; ++q) { const f32x4 x0 = SST[q * 64], x1 = SST[(4 + q) * 64];
#pragma unroll
                for (int e = 0; e < 4; ++e) { S0[4 * q + e] = x0[e]; S1[4 * q + e] = x1[e]; } }
#define RWC_ROWFRAG(arr, row, s_) (*(const LAS bf16x8*)((arr) + (row) * 72 + 16 * (s_) + 8 * hh))
#define RWC_PACK(dst, T, s_) do { u32x4 p_; p_.x = cvtpk((T)[8 * (s_) + 0], (T)[8 * (s_) + 1]); p_.y = cvtpk((T)[8 * (s_) + 2], (T)[8 * (s_) + 3]); p_.z = cvtpk((T)[8 * (s_) + 4], (T)[8 * (s_) + 5]); p_.w = cvtpk((T)[8 * (s_) + 6], (T)[8 * (s_) + 7]); dst = __builtin_bit_cast(bf16x8, p_); } while (0)
#define RWC_PACKM(dst, T, s_, M0, M1) do { u32x4 p_; const u32x4 mm_ = (s_) == 0 ? (M0) : (M1); p_.x = cvtpk((T)[8 * (s_) + 0], (T)[8 * (s_) + 1]) & mm_.x; p_.y = cvtpk((T)[8 * (s_) + 2], (T)[8 * (s_) + 3]) & mm_.y; p_.z = cvtpk((T)[8 * (s_) + 4], (T)[8 * (s_) + 5]) & mm_.z; p_.w = cvtpk((T)[8 * (s_) + 6], (T)[8 * (s_) + 7]) & mm_.w; dst = __builtin_bit_cast(bf16x8, p_); } while (0)
#define RWC_PERM(dst, ptr) do { const u32x2 q0_ = *(const LAS u32x2*)(ptr), q1_ = *(const LAS u32x2*)((ptr) + 8); const u32x4 q_ = {q0_.x, q0_.y, q1_.x, q1_.y}; dst = __builtin_bit_cast(bf16x8, q_); } while (0)
            f32x16 Nm, Nt, X2, Wm;
#pragma unroll
            for (int i = 0; i < 16; ++i) { Nm[i] = 0.f; Nt[i] = 0.f; X2[i] = 0.f; Wm[i] = 0.f; }
#pragma unroll
            for (int s_ = 0; s_ < 4; ++s_) {
                const bf16x8 fa = RWC_ROWFRAG(AH, r32, s_), fb = RWC_ROWFRAG(BC, r32, s_), fk = RWC_ROWFRAG(KC, r32, s_);
                Nm = __builtin_amdgcn_mfma_f32_32x32x16_bf16(fa, fb, Nm, 0, 0, 0);
                Nt = __builtin_amdgcn_mfma_f32_32x32x16_bf16(fb, fa, Nt, 0, 0, 0);
                X2 = __builtin_amdgcn_mfma_f32_32x32x16_bf16(fk, fa, X2, 0, 0, 0);
            }
            const LAS u32x4* mkp = (const LAS u32x4*)(MSK + lane * 8);
            const u32x4 mN0 = mkp[0], mN1 = mkp[1], mT0 = mkp[128], mT1 = mkp[129];
            __builtin_amdgcn_sched_barrier(0);
#pragma unroll
            for (int kb = 0; kb < 2; ++kb)
#pragma unroll
                for (int s_ = 0; s_ < 2; ++s_) { bf16x8 fa, fs; RWC_PERM(fa, A0 + r32 * 72 + kb * 32 + 16 * s_ + 4 * hh); if (kb == 0) RWC_PACK(fs, S0, s_); else RWC_PACK(fs, S1, s_);
                    Wm = __builtin_amdgcn_mfma_f32_32x32x16_bf16(fa, fs, Wm, 0, 0, 0); }
#pragma unroll
            for (int s_ = 0; s_ < 2; ++s_) { bf16x8 fx, fv; RWC_PACKM(fx, X2, s_, mT0, mT1); RWC_PERM(fv, VT + (vt * 32 + r32) * 40 + 16 * s_ + 4 * hh);
                Wm = __builtin_amdgcn_mfma_f32_32x32x16_bf16(fx, fv, Wm, 0, 0, 0); }
            __builtin_amdgcn_sched_barrier(0);
#pragma unroll
            for (int lvl = 0; lvl < 5; ++lvl) {
                bf16x8 q0, q1, w0, w1; if (lvl == 0) { RWC_PACKM(q0, Nt, 0, mT0, mT1); RWC_PACKM(q1, Nt, 1, mT0, mT1); } else { RWC_PACK(q0, Nt, 0); RWC_PACK(q1, Nt, 1); } RWC_PACK(w0, Wm, 0); RWC_PACK(w1, Wm, 1);
                Wm = __builtin_amdgcn_mfma_f32_32x32x16_bf16(q0, w0, Wm, 0, 0, 0);
                Wm = __builtin_amdgcn_mfma_f32_32x32x16_bf16(q1, w1, Wm, 0, 0, 0);
                if (lvl < 4) {
                    bf16x8 p0, p1; if (lvl == 0) { RWC_PACKM(p0, Nm, 0, mN0, mN1); RWC_PACKM(p1, Nm, 1, mN0, mN1); } else { RWC_PACK(p0, Nm, 0); RWC_PACK(p1, Nm, 1); }
                    f32x16 P2, Q2;
#pragma unroll
                    for (int i = 0; i < 16; ++i) { P2[i] = 0.f; Q2[i] = 0.f; }
                    P2 = __builtin_amdgcn_mfma_f32_32x32x16_bf16(q0, p0, P2, 0, 0, 0);
                    Q2 = __builtin_amdgcn_mfma_f32_32x32x16_bf16(p0, q0, Q2, 0, 0, 0);
                    P2 = __builtin_amdgcn_mfma_f32_32x32x16_bf16(q1, p1, P2, 0, 0, 0);
                    Q2 = __builtin_amdgcn_mfma_f32_32x32x16_bf16(p1, q1, Q2, 0, 0, 0);
                    Nm = P2; Nt = Q2;
                }
                __builtin_amdgcn_sched_barrier(0);
            }
#pragma unroll
            for (int q4 = 0; q4 < 4; ++q4) *(LAS u32x2*)(SAT + (vt * 32 + r32) * 40 + 8 * q4 + 4 * hh) = (u32x2){cvtpk(Wm[4 * q4 + 0], Wm[4 * q4 + 1]), cvtpk(Wm[4 * q4 + 2], Wm[4 * q4 + 3])};
            __builtin_amdgcn_sched_barrier(0);
            if (seg == 1) {
                f32x16 X3, X4, Ym;
#pragma unroll
                for (int i = 0; i < 16; ++i) { X3[i] = 0.f; X4[i] = 0.f; Ym[i] = 0.f; }
#pragma unroll
                for (int s_ = 0; s_ < 4; ++s_) {
                    const bf16x8 fr = RWC_ROWFRAG(RH, r32, s_), fb = RWC_ROWFRAG(BC, r32, s_), fk = RWC_ROWFRAG(KC, r32, s_);
                    X3 = __builtin_amdgcn_mfma_f32_32x32x16_bf16(fb, fr, X3, 0, 0, 0);
                    X4 = __builtin_amdgcn_mfma_f32_32x32x16_bf16(fk, fr, X4, 0, 0, 0);
                }
                const u32x4 mX0 = mkp[256], mX1 = mkp[257];
#pragma unroll
                for (int kb = 0; kb < 2; ++kb)
#pragma unroll
                    for (int s_ = 0; s_ < 2; ++s_) { bf16x8 fa, fs; RWC_PERM(fa, R0 + r32 * 72 + kb * 32 + 16 * s_ + 4 * hh); if (kb == 0) RWC_PACK(fs, S0, s_); else RWC_PACK(fs, S1, s_);
                        Ym = __builtin_amdgcn_mfma_f32_32x32x16_bf16(fa, fs, Ym, 0, 0, 0); }
#pragma unroll
                for (int s_ = 0; s_ < 2; ++s_) { bf16x8 fx3, fx4, fsa, fv; RWC_PACKM(fx3, X3, s_, mX0, mX1); RWC_PACKM(fx4, X4, s_, mX0, mX1);
                    RWC_PERM(fsa, SAT + (vt * 32 + r32) * 40 + 16 * s_ + 4 * hh); RWC_PERM(fv, VT + (vt * 32 + r32) * 40 + 16 * s_ + 4 * hh);
                    Ym = __builtin_amdgcn_mfma_f32_32x32x16_bf16(fx3, fsa, Ym, 0, 0, 0);
                    Ym = __builtin_amdgcn_mfma_f32_32x32x16_bf16(fx4, fv, Ym, 0, 0, 0); }
#pragma unroll
                for (int i = 0; i < 16; ++i) LY[((i & 3) + 8 * (i >> 2) + 4 * hh) * 64 + vt * 32 + r32] = Ym[i];
            }
            __builtin_amdgcn_sched_barrier(0);
#pragma unroll
            for (int q4 = 0; q4 < 4; ++q4) {
                const f32x4 g0 = *(const LAS f32x4*)(LGK + 8 * q4 + 4 * hh), g1 = *(const LAS f32x4*)(LGK + 32 + 8 * q4 + 4 * hh);
#pragma unroll
                for (int e = 0; e < 4; ++e) { S0[4 * q4 + e] *= g0[e]; S1[4 * q4 + e] *= g1[e]; }
            }
#pragma unroll
            for (int s_ = 0; s_ < 2; ++s_) {
                const bf16x8 fsa = *(const LAS bf16x8*)(SAT + (vt * 32 + r32) * 40 + 16 * s_ + 8 * hh), fv = *(const LAS bf16x8*)(VT + (vt * 32 + r32) * 40 + 16 * s_ + 8 * hh);
                const bf16x8 b0 = *(const LAS bf16x8*)(BBT + r32 * 40 + 16 * s_ + 8 * hh), b1 = *(const LAS bf16x8*)(BBT + (32 + r32) * 40 + 16 * s_ + 8 * hh);
                const bf16x8 k0 = *(const LAS bf16x8*)(KBT + r32 * 40 + 16 * s_ + 8 * hh), k1 = *(const LAS bf16x8*)(KBT + (32 + r32) * 40 + 16 * s_ + 8 * hh);
                S0 = __builtin_amdgcn_mfma_f32_32x32x16_bf16(b0, fsa, S0, 0, 0, 0); S0 = __builtin_amdgcn_mfma_f32_32x32x16_bf16(k0, fv, S0, 0, 0, 0);
                S1 = __builtin_amdgcn_mfma_f32_32x32x16_bf16(b1, fsa, S1, 0, 0, 0); S1 = __builtin_amdgcn_mfma_f32_32x32x16_bf16(k1, fv, S1, 0, 0, 0);
            }
#pragma unroll
            for (int q = 0; q < 4; ++q) { SST[q * 64] = (f32x4){S0[4 * q], S0[4 * q + 1], S0[4 * q + 2], S0[4 * q + 3]}; SST[(4 + q) * 64] = (f32x4){S1[4 * q], S1[4 * q + 1], S1[4 * q + 2], S1[4 * q + 3]}; }
#undef RWC_ROWFRAG
#undef RWC_PACK
#undef RWC_PACKM
#undef RWC_PERM
        } else {
          if (wave < 6 && seg == 1) {
              const int tq2 = tl - 128, p = tq2 >> 3, part = tq2 & 7;
              const f32x4 a0 = *(const LAS f32x4*)(CSV + p * 64 + 8 * part), a1 = *(const LAS f32x4*)(CSV + p * 64 + 8 * part + 4);
              const float tot = oct_sum((a0.x + a0.y) + (a0.z + a0.w) + (a1.x + a1.y) + (a1.z + a1.w));
              if (part == 0) CSC[(size_t)(rowbase + t0 + dir * p) * 8 + h] = tot;
          }
          if (cgi + 1 < 72 && !sk_conv) {
            const int tq = tl - 128; RW_PREA(cgi + 1, tq);
            { const int cn2 = cgi + 2 < 72 ? cgi + 2 : 71; RW_TAPS(tp0, cn2, tq); RW_LRAW(cn2, tq); }
          }
        }
        LDS_BARRIER();
    }
    if (!nostore) {
        RW_PTRS();
        RW_GEOM(71, segp, Lsp, rbp, t0p); (void)Lsp; (void)segp;
        const int dirp = d == 0 ? 1 : -1, s_ = tid >> 4, v0 = 4 * (tid & 15), t = t0p + dirp * s_;
        const f32x4 yv = *(const LAS f32x4*)(LY + s_ * 64 + v0);
        u32x2 w; w.x = cvtpk(yv.x, yv.y); w.y = cvtpk(yv.z, yv.w);
        *(GAS u32x2*)(YRW + (size_t)(rbp + t) * 512 + h * 64 + v0) = w;
    }
#undef RW_GEOM
#undef RW_LOAD0
#undef RW_TAPGEO
#undef RW_TAPQ
#undef RW_LRAW
#undef RW_LOAD1
#undef RW_CONV2
#undef RW_CONV_EPI
#undef RW_PREA
#undef RW_PTRS
    LDS_BARRIER();
}

template <int CTRL, int RMASK> __device__ __forceinline__ float dppz(float x) { return __builtin_bit_cast(float, __builtin_amdgcn_update_dpp(0, __builtin_bit_cast(int, x), CTRL, RMASK, 0xf, false)); }
__device__ __forceinline__ float scan32(float x) {
    x += dppz<0x111, 0xf>(x); x += dppz<0x112, 0xf>(x); x += dppz<0x114, 0xf>(x); x += dppz<0x118, 0xf>(x); x += dppz<0x142, 0xa>(x); return x;
}
template <int LANE> __device__ __forceinline__ float bcast32(float x) {
    return __builtin_bit_cast(float, __builtin_amdgcn_ds_swizzle(__builtin_bit_cast(int, x), LANE << 5));
}
__device__ __forceinline__ void hgrn_unit(Frame& F, int b, int h, int d) {
    LAUNDER(F);
    int tl0 = F.tid; asm volatile("" : "+v"(tl0));
    const int tid = tl0, wave = F.wave;
    const GAS bf16_t* CHG = (const GAS bf16_t*)(F.ws + WS_CHG);
    GAS bf16_t* OHG = (GAS bf16_t*)F.out + (size_t)2 * NT * 512 + (size_t)d * NT * 512;
    LAS unsigned char* LB_ = F.lds;
    constexpr int IMGB = 24320, O_KT2 = 4608, O_QH = 9216, O_KHT = 13824, O_IVT = 18944, O_LGK = 24064;
    LAS float* LO = (LAS float*)(LB_ + 2 * IMGB);
    const int pp = tid & 31, cs = (tid >> 5) & 1, wv = (wave - 4) & 3;
    const int c4a = 4 * (2 * wv + cs), c4b = c4a + 32;
    float lba[4], lbb[4];
#pragma unroll
    for (int e = 0; e < 4; ++e) { const int ca = h * 64 + c4a + e, cb = h * 64 + c4b + e;
        lba[e] = fsigmoid(F.inp[I_LB][(d * 2 + 0) * 512 + ca] - F.inp[I_LB][(d * 2 + 1) * 512 + ca]); lbb[e] = fsigmoid(F.inp[I_LB][(d * 2 + 0) * 512 + cb] - F.inp[I_LB][(d * 2 + 1) * 512 + cb]); }
    f32x16 S0, S1;
#pragma unroll
    for (int i = 0; i < 16; ++i) { S0[i] = 0.f; S1[i] = 0.f; }
    struct Raw { u32x2 qa, fa, ia, qb, fb, ib; };
    Raw rA, rB;
    rA.qa = rA.fa = rA.ia = rA.qb = rA.fb = rA.ib = (u32x2){0u, 0u}; rB = rA;
    f32x4 tvA[8], tvB[8];
#pragma unroll
    for (int i = 0; i < 8; ++i) { tvA[i] = (f32x4){0.f, 0.f, 0.f, 0.f}; tvB[i] = (f32x4){0.f, 0.f, 0.f, 0.f}; }
#define HG_LOAD(cg, R) do { const int seg_ = (cg) < 8 ? 0 : 1, Ls_ = seg_ == 0 ? CTXL : SEQ, rb_ = seg_ == 0 ? NT + b * CTXL : b * SEQ, ci_ = (cg) - (seg_ ? 8 : 0); \
        const int t_ = d == 0 ? ci_ * TCS + pp : Ls_ - 1 - ci_ * TCS - pp; const GAS bf16_t* rp = CHG + (size_t)(rb_ + t_) * LD_HG + h * 64 + c4a; \
        (R).qa = *(const GAS u32x2*)rp; (R).fa = *(const GAS u32x2*)(rp + 512 + d * 512); (R).ia = *(const GAS u32x2*)(rp + 1536); \
        (R).qb = *(const GAS u32x2*)(rp + 32); (R).fb = *(const GAS u32x2*)(rp + 32 + 512 + d * 512); (R).ib = *(const GAS u32x2*)(rp + 32 + 1536); } while (0)
#define HG_IMAGE(img, rq, rf, ri, lb, c4) do { \
        const float q_[4] = {bflo(rq.x), bfhi(rq.x), bflo(rq.y), bfhi(rq.y)}, f_[4] = {bflo(rf.x), bfhi(rf.x), bflo(rf.y), bfhi(rf.y)}; \
        float cum_[4], qs_[4], kf_[4]; \
        _Pragma("unroll") for (int e = 0; e < 4; ++e) { const float sg = fsigmoid(f_[e]); qs_[e] = fsilu(q_[e]) * 0.125f; cum_[e] = __builtin_amdgcn_logf(lb[e] + (1.0f - lb[e]) * sg); kf_[e] = (1.0f - lb[e]) * (1.0f - sg); } \
        _Pragma("unroll") for (int e = 0; e < 4; ++e) cum_[e] = scan32(cum_[e]); \
        float a_[4], b_[4], c_[4], d_[4], l_[4]; \
        _Pragma("unroll") for (int e = 0; e < 4; ++e) { const float ref = bcast32<16>(cum_[e]); \
            const float ecv = __builtin_amdgcn_exp2f(cum_[e] - ref), eicv = __builtin_amdgcn_exp2f(ref - cum_[e]), ehv = __builtin_amdgcn_exp2f(cum_[e]); \
            a_[e] = qs_[e] * ecv; b_[e] = kf_[e] * eicv; c_[e] = qs_[e] * ehv; \
            d_[e] = b_[e] * bcast32<31>(ecv);      \
            l_[e] = bcast32<31>(ehv); }              \
        *(LAS u32x2*)((img) + (pp * 72 + (c4)) * 2) = (u32x2){cvtpk(a_[0], a_[1]), cvtpk(a_[2], a_[3])}; \
        *(LAS u32x2*)((img) + O_KT2 + (pp * 72 + (c4)) * 2) = (u32x2){cvtpk(b_[0], b_[1]), cvtpk(b_[2], b_[3])}; \
        *(LAS u32x2*)((img) + O_QH + (pp * 72 + (c4)) * 2) = (u32x2){cvtpk(c_[0], c_[1]), cvtpk(c_[2], c_[3])}; \
        _Pragma("unroll") for (int e = 0; e < 4; ++e) *(LAS bf16_t*)((img) + O_KHT + (((c4) + e) * 40 + pp) * 2) = cvt1(d_[e]); \
        *(LAS bf16_t*)((img) + O_IVT + (((c4) + 0) * 40 + pp) * 2) = (bf16_t)(ri.x & 0xffffu); *(LAS bf16_t*)((img) + O_IVT + (((c4) + 1) * 40 + pp) * 2) = (bf16_t)(ri.x >> 16); \
        *(LAS bf16_t*)((img) + O_IVT + (((c4) + 2) * 40 + pp) * 2) = (bf16_t)(ri.y & 0xffffu); *(LAS bf16_t*)((img) + O_IVT + (((c4) + 3) * 40 + pp) * 2) = (bf16_t)(ri.y >> 16); \
        if (pp == 31) *(LAS f32x4*)((img) + O_LGK + (c4) * 4) = (f32x4){l_[0], l_[1], l_[2], l_[3]}; } while (0)
    LDS_BARRIER();
    if (wave >= 4) {
        HG_LOAD(0, rA);
        HG_LOAD(1, rB);
        HG_IMAGE(LB_, rA.qa, rA.fa, rA.ia, lba, c4a); HG_IMAGE(LB_, rA.qb, rA.fb, rA.ib, lbb, c4b);
        HG_LOAD(2, rA);
    }
    LDS_BARRIER();
#define HG_OUT(cg) do { if ((cg) >= 9) { int tl = tid; asm volatile("" : "+v"(tl));     \
            const int ci = (cg) - 9, t0 = d == 0 ? ci * TCS : SEQ - 1 - ci * TCS, dir = d == 0 ? 1 : -1; \
            _Pragma("unroll") for (int hf = 0; hf < 2; ++hf) { const int s = (tl >> 4) + 16 * hf, v0 = 4 * (tl & 15), t = t0 + dir * s; \
                const f32x4 yv = *(const LAS f32x4*)(LO + (((cg) - 1) & 1) * 2048 + s * 64 + v0); \
                u32x2 w; w.x = cvtpk(yv.x, yv.y); w.y = cvtpk(yv.z, yv.w); \
                *(GAS u32x2*)(OHG + (size_t)(b * SEQ + t) * 512 + h * 64 + v0) = w; } } } while (0)
    if (wave >= 4) {
#define HG_IMG_ITER(cg, R) do { if ((cg) + 1 < 72) { LAS unsigned char* img = LB_ + (((cg) + 1) & 1) * IMGB; \
            HG_IMAGE(img, (R).qa, (R).fa, (R).ia, lba, c4a); HG_IMAGE(img, (R).qb, (R).fb, (R).ib, lbb, c4b); \
            const int cn_ = (cg) + 3 < 72 ? (cg) + 3 : 71; HG_LOAD(cn_, R); } LDS_BARRIER(); } while (0)
#pragma unroll 1
        for (int cg2 = 0; cg2 < 72; cg2 += 2) { HG_IMG_ITER(cg2, rB); HG_IMG_ITER(cg2 + 1, rA); }
#undef HG_IMG_ITER
    } else if (wave < 2) {
#pragma unroll 1
      for (int cg = 0; cg < 72; ++cg) {
        HG_OUT(cg);
        int tl = tid; asm volatile("" : "+v"(tl));
        const int lane = tl & 63;
        {
            const int vt = wave, r32 = lane & 31, hh = lane >> 5;
            LAS unsigned char* img = LB_ + (cg & 1) * IMGB;
            const LAS bf16_t* QT = (const LAS bf16_t*)img; const LAS bf16_t* KT2 = (const LAS bf16_t*)(img + O_KT2); const LAS bf16_t* QH = (const LAS bf16_t*)(img + O_QH);
            const LAS bf16_t* KHT = (const LAS bf16_t*)(img + O_KHT); const LAS bf16_t* IVT = (const LAS bf16_t*)(img + O_IVT); const LAS float* LGK = (const LAS float*)(img + O_LGK);
            if (cg >= 8) {
                f32x16 X;
#pragma unroll
                for (int i = 0; i < 16; ++i) X[i] = 0.f;
#pragma unroll
                for (int s = 0; s < 4; ++s) {
                    const bf16x8 af = *(const LAS bf16x8*)(KT2 + r32 * 72 + 16 * s + 8 * hh), bf = *(const LAS bf16x8*)(QT + r32 * 72 + 16 * s + 8 * hh);
                    X = __builtin_amdgcn_mfma_f32_32x32x16_bf16(af, bf, X, 0, 0, 0);
                }
#pragma unroll
                for (int i = 0; i < 16; ++i) { const int j = (i & 3) + 8 * (i >> 2) + 4 * hh; if (j > r32) X[i] = 0.f; }
                f32x16 o;
#pragma unroll
                for (int i = 0; i < 16; ++i) o[i] = 0.f;
#pragma unroll
                for (int s = 0; s < 2; ++s) {
                    u32x4 xa; xa.x = cvtpk(X[8 * s + 0], X[8 * s + 1]); xa.y = cvtpk(X[8 * s + 2], X[8 * s + 3]); xa.z = cvtpk(X[8 * s + 4], X[8 * s + 5]); xa.w = cvtpk(X[8 * s + 6], X[8 * s + 7]);
                    const LAS bf16_t* ip = IVT + (vt * 32 + r32) * 40 + 16 * s + 4 * hh;
                    const u32x2 b0 = *(const LAS u32x2*)ip, b1 = *(const LAS u32x2*)(ip + 8);
                    const u32x4 bb = {b0.x, b0.y, b1.x, b1.y};
                    o = __builtin_amdgcn_mfma_f32_32x32x16_bf16(__builtin_bit_cast(bf16x8, xa), __builtin_bit_cast(bf16x8, bb), o, 0, 0, 0);
                }
#pragma unroll
                for (int kb = 0; kb < 2; ++kb)
#pragma unroll
                    for (int s = 0; s < 2; ++s) {
                        u32x4 sb;
                        if (kb == 0) { sb.x = cvtpk(S0[8 * s + 0], S0[8 * s + 1]); sb.y = cvtpk(S0[8 * s + 2], S0[8 * s + 3]); sb.z = cvtpk(S0[8 * s + 4], S0[8 * s + 5]); sb.w = cvtpk(S0[8 * s + 6], S0[8 * s + 7]); }
                        else { sb.x = cvtpk(S1[8 * s + 0], S1[8 * s + 1]); sb.y = cvtpk(S1[8 * s + 2], S1[8 * s + 3]); sb.z = cvtpk(S1[8 * s + 4], S1[8 * s + 5]); sb.w = cvtpk(S1[8 * s + 6], S1[8 * s + 7]); }
                        const LAS bf16_t* qp = QH + r32 * 72 + kb * 32 + 16 * s + 4 * hh;
                        const u32x2 a0 = *(const LAS u32x2*)qp, a1 = *(const LAS u32x2*)(qp + 8);
                        const u32x4 aa = {a0.x, a0.y, a1.x, a1.y};
                        o = __builtin_amdgcn_mfma_f32_32x32x16_bf16(__builtin_bit_cast(bf16x8, aa), __builtin_bit_cast(bf16x8, sb), o, 0, 0, 0);
                    }
                LAS float* LOw = LO + (cg & 1) * 2048;
#pragma unroll
                for (int i = 0; i < 16; ++i) { const int p = (i & 3) + 8 * (i >> 2) + 4 * hh; LOw[p * 64 + vt * 32 + r32] = o[i]; }
            }
#pragma unroll
            for (int q4 = 0; q4 < 4; ++q4) {
                const f32x4 g0 = *(const LAS f32x4*)(LGK + 8 * q4 + 4 * hh), g1 = *(const LAS f32x4*)(LGK + 32 + 8 * q4 + 4 * hh);
#pragma unroll
                for (int e = 0; e < 4; ++e) { S0[4 * q4 + e] *= g0[e]; S1[4 * q4 + e] *= g1[e]; }
            }
#pragma unroll
            for (int s = 0; s < 2; ++s) {
                const bf16x8 bf = *(const LAS bf16x8*)(IVT + (vt * 32 + r32) * 40 + 16 * s + 8 * hh);
                const bf16x8 a0 = *(const LAS bf16x8*)(KHT + r32 * 40 + 16 * s + 8 * hh), a1 = *(const LAS bf16x8*)(KHT + (32 + r32) * 40 + 16 * s + 8 * hh);
                S0 = __builtin_amdgcn_mfma_f32_32x32x16_bf16(a0, bf, S0, 0, 0, 0);
                S1 = __builtin_amdgcn_mfma_f32_32x32x16_bf16(a1, bf, S1, 0, 0, 0);
            }
        }
        LDS_BARRIER();
      }
    } else {
        LAS float* scr = (LAS float*)(F.lds + 75776 + (wave - 2) * 8448);
#define HG_CONV_ITER(cg, tv) do { HG_OUT(cg); const int lane_ = tid & 63; \
            if ((cg) >= 2) { const int idx = F.bid + F.G * ((wave - 2) + 2 * ((cg) - 2)); if (idx < NEXP_ITEMS) { const ExpItem it = exp_item(F, idx); tr_finish<true>(tv, it.K, it.N, it.WT, it.row_mul, it.row_add, scr, it.sub, lane_); } } \
            { int idx = F.bid + F.G * ((wave - 2) + 2 * (cg)); idx = idx < NEXP_ITEMS ? idx : NEXP_ITEMS - 1; const ExpItem it = exp_item(F, idx); tr_load<true>(it.W, it.N, it.sub, lane_, tv); } \
            LDS_BARRIER(); } while (0)
#pragma unroll 1
        for (int cg2 = 0; cg2 < 72; cg2 += 2) { HG_CONV_ITER(cg2, tvA); HG_CONV_ITER(cg2 + 1, tvB); }
#undef HG_CONV_ITER
    }
#undef HG_OUT
    {
        const int ci = 63, t0 = d == 0 ? ci * TCS : SEQ - 1 - ci * TCS, dir = d == 0 ? 1 : -1;
        const int s = tid >> 4, v0 = 4 * (tid & 15), t = t0 + dir * s;
        const f32x4 yv = *(const LAS f32x4*)(LO + (71 & 1) * 2048 + s * 64 + v0);
        u32x2 w; w.x = cvtpk(yv.x, yv.y); w.y = cvtpk(yv.z, yv.w);
        *(GAS u32x2*)(OHG + (size_t)(b * SEQ + t) * 512 + h * 64 + v0) = w;
    }
#undef HG_LOAD
#undef HG_IMAGE
    LDS_BARRIER();
}

__device__ __forceinline__ void post_phase(Frame& F) {
    LAUNDER(F);
    int tl_ = F.tid; asm volatile("" : "+v"(tl_));
    const int lane = tl_ & 63, wave = F.wave;
    GAS bf16_t* CRW = (GAS bf16_t*)(F.ws + WS_CRW);
    const GAS bf16_t* CHG = (const GAS bf16_t*)(F.ws + WS_CHG);
    const GAS bf16_t* G2T = (const GAS bf16_t*)(F.ws + WS_G2T);
    const GAS bf16_t* YRW = (const GAS bf16_t*)F.out; const GAS bf16_t* OHG = YRW + (size_t)2 * NT * 512;
    const GAS bf16_t* VCONV = (const GAS bf16_t*)(F.ws + WS_VCONV);
    const GAS float* CSC = (const GAS float*)(F.ws + WS_CSC);
    LAS float* LG = (LAS float*)F.lds;
    LAS bf16_t* SA = (LAS bf16_t*)(F.lds + 65536);
    const int c0 = 8 * lane, hd = lane >> 3;
    const int sr = lane & 31, hh = lane >> 5;
    LAS float* PC = (LAS float*)(F.lds + 65536 + 32 * 136 * 2);
    { const int t_ = tl_; PC[t_] = F.inp[I_LNG][t_]; PC[512 + t_] = F.inp[I_LNB][t_]; if (t_ < 64) PC[1024 + t_] = F.inp[I_HGN][t_]; }
    bf16x8 bfr[2][8];
#pragma unroll
    for (int ci = 0; ci < 2; ++ci) { const GAS bf16_t* bp = G2T + (size_t)((2 * wave + ci) * 32 + sr) * 128 + 8 * hh;
#pragma unroll
        for (int js = 0; js < 8; ++js) bfr[ci][js] = *(const GAS bf16x8*)(bp + 16 * js); }
    u32x4 gdn = *(const GAS u32x4*)(CRW + (size_t)(F.bid * 32 + 4 * wave + (lane >> 4)) * LD_RW + 1792 + 8 * (lane & 15));
#pragma unroll 1
  for (int tile = F.bid; tile < NT / 32; tile += F.G) {
    const int row0 = tile * 32;
    { const int r_ = 4 * wave + (lane >> 4), cc = 8 * (lane & 15);
      const u32x4 raw = gdn;
      { const int tn = tile + F.G < NT / 32 ? tile + F.G : tile; gdn = *(const GAS u32x4*)(CRW + (size_t)(tn * 32 + r_) * LD_RW + 1792 + cc); }
      float f[8] = {bflo(raw.x), bfhi(raw.x), bflo(raw.y), bfhi(raw.y), bflo(raw.z), bfhi(raw.z), bflo(raw.w), bfhi(raw.w)};
#pragma unroll
      for (int e = 0; e < 8; ++e) f[e] = fsigmoid(f[e]);
      *(LAS u32x4*)(SA + r_ * 136 + cc) = (u32x4){cvtpk(f[0], f[1]), cvtpk(f[2], f[3]), cvtpk(f[4], f[5]), cvtpk(f[6], f[7])}; }
    u32x4 ya[4], yb[4], vr[4], oa[4], ob[4], gr[4]; float csv[4];
#pragma unroll
    for (int i = 0; i < 4; ++i) { const int row = row0 + 4 * wave + i;
        ya[i] = *(const GAS u32x4*)(YRW + (size_t)row * 512 + c0); yb[i] = *(const GAS u32x4*)(YRW + (size_t)NT * 512 + (size_t)row * 512 + c0);
        vr[i] = *(const GAS u32x4*)(VCONV + (size_t)row * 512 + c0);
        oa[i] = *(const GAS u32x4*)(OHG + (size_t)row * 512 + c0); ob[i] = *(const GAS u32x4*)(OHG + (size_t)NT * 512 + (size_t)row * 512 + c0);
        gr[i] = *(const GAS u32x4*)(CHG + (size_t)row * LD_HG + 2048 + c0);
        csv[i] = CSC[(size_t)row * 8 + hd] + CSC[(size_t)NT * 8 + (size_t)row * 8 + hd]; }
    LDS_BARRIER();
    {
        f32x16 acc0, acc1;
#pragma unroll
        for (int i = 0; i < 16; ++i) { acc0[i] = 0.f; acc1[i] = 0.f; }
#pragma unroll
        for (int js = 0; js < 8; ++js) { const bf16x8 af = *(const LAS bf16x8*)(SA + sr * 136 + 16 * js + 8 * hh);
            acc0 = __builtin_amdgcn_mfma_f32_32x32x16_bf16(af, bfr[0][js], acc0, 0, 0, 0); acc1 = __builtin_amdgcn_mfma_f32_32x32x16_bf16(af, bfr[1][js], acc1, 0, 0, 0); }
#pragma unroll
        for (int i = 0; i < 16; ++i) { const int srow = (i & 3) + 8 * (i >> 2) + 4 * hh; LG[srow * 512 + (2 * wave) * 32 + sr] = acc0[i]; LG[srow * 512 + (2 * wave + 1) * 32 + sr] = acc1[i]; }
    }
    LDS_BARRIER();
#pragma unroll
    for (int i = 0; i < 4; ++i) {
        const int tl = 4 * wave + i, row = row0 + tl;
        float y[8] = {bflo(ya[i].x) + bflo(yb[i].x), bfhi(ya[i].x) + bfhi(yb[i].x), bflo(ya[i].y) + bflo(yb[i].y), bfhi(ya[i].y) + bfhi(yb[i].y), bflo(ya[i].z) + bflo(yb[i].z), bfhi(ya[i].z) + bfhi(yb[i].z), bflo(ya[i].w) + bflo(yb[i].w), bfhi(ya[i].w) + bfhi(yb[i].w)};
        float sm = 0.f;
#pragma unroll
        for (int e = 0; e < 8; ++e) sm += y[e];
        sm = oct_sum(sm);
        const float mu = sm * (1.f / 64.f);
        float sq = 0.f;
#pragma unroll
        for (int e = 0; e < 8; ++e) { const float dlt = y[e] - mu; sq += dlt * dlt; }
        sq = oct_sum(sq);
        const float rs = __builtin_amdgcn_rsqf(sq * (1.f / 64.f) + 64e-5f);
        const float cs = csv[i];
        const float vv[8] = {bflo(vr[i].x), bfhi(vr[i].x), bflo(vr[i].y), bfhi(vr[i].y), bflo(vr[i].z), bfhi(vr[i].z), bflo(vr[i].w), bfhi(vr[i].w)};
        const f32x4 g0 = *(const LAS f32x4*)(LG + tl * 512 + c0), g1 = *(const LAS f32x4*)(LG + tl * 512 + c0 + 4);
        const float gv[8] = {g0.x, g0.y, g0.z, g0.w, g1.x, g1.y, g1.z, g1.w};
        float o[8];
        const f32x4 lg0 = *(const LAS f32x4*)(PC + c0), lg1 = *(const LAS f32x4*)(PC + c0 + 4), lb0 = *(const LAS f32x4*)(PC + 512 + c0), lb1 = *(const LAS f32x4*)(PC + 512 + c0 + 4);
        const float lng[8] = {lg0.x, lg0.y, lg0.z, lg0.w, lg1.x, lg1.y, lg1.z, lg1.w}, lnb[8] = {lb0.x, lb0.y, lb0.z, lb0.w, lb1.x, lb1.y, lb1.z, lb1.w};
#pragma unroll
        for (int e = 0; e < 8; ++e) { const float yn = (y[e] - mu) * rs * lng[e] + lnb[e] + cs * vv[e]; o[e] = yn * gv[e]; }
        u32x4 w1; w1.x = cvtpk(o[0], o[1]); w1.y = cvtpk(o[2], o[3]); w1.z = cvtpk(o[4], o[5]); w1.w = cvtpk(o[6], o[7]);
        float z[8] = {bflo(oa[i].x) + bflo(ob[i].x), bfhi(oa[i].x) + bfhi(ob[i].x), bflo(oa[i].y) + bflo(ob[i].y), bfhi(oa[i].y) + bfhi(ob[i].y), bflo(oa[i].z) + bflo(ob[i].z), bfhi(oa[i].z) + bfhi(ob[i].z), bflo(oa[i].w) + bflo(ob[i].w), bfhi(oa[i].w) + bfhi(ob[i].w)};
        float zq = 0.f;
#pragma unroll
        for (int e = 0; e < 8; ++e) zq += z[e] * z[e];
        zq = oct_sum(zq);
        const float zr = __builtin_amdgcn_rsqf(zq * (1.f / 64.f) + 1e-6f);
        const float gg[8] = {bflo(gr[i].x), bfhi(gr[i].x), bflo(gr[i].y), bfhi(gr[i].y), bflo(gr[i].z), bfhi(gr[i].z), bflo(gr[i].w), bfhi(gr[i].w)};
        float p[8];
        const f32x4 hn0 = *(const LAS f32x4*)(PC + 1024 + (c0 & 63)), hn1 = *(const LAS f32x4*)(PC + 1024 + (c0 & 63) + 4);
        const float hgn[8] = {hn0.x, hn0.y, hn0.z, hn0.w, hn1.x, hn1.y, hn1.z, hn1.w};
#pragma unroll
        for (int e = 0; e < 8; ++e) p[e] = z[e] * zr * hgn[e] * fsilu(gg[e]);
        u32x4 w2; w2.x = cvtpk(p[0], p[1]); w2.y = cvtpk(p[2], p[3]); w2.z = cvtpk(p[4], p[5]); w2.w = cvtpk(p[6], p[7]);
        *(GAS u32x4*)(CRW + (size_t)row * LD_RW + c0) = w1;
        *(GAS u32x4*)(CRW + (size_t)row * LD_RW + 512 + c0) = w2;
    }
    LDS_BARRIER();
  }
}

__device__ __forceinline__ void route_phase(Frame& F) {
    LAUNDER(F);
    const int tid = F.tid, lane = F.lane, wave = F.wave, bid = F.bid;
    const GAS bf16_t* X1B = (const GAS bf16_t*)(F.ws + WS_X1B); const GAS float* MODF = (const GAS float*)(F.ws + WS_MODF); const GAS bf16_t* RWT = (const GAS bf16_t*)(F.ws + WS_RWT);
    GAS bf16_t* H2 = (GAS bf16_t*)(F.ws + WS_H2);
    int* SLOT = (int*)(F.ws + WS_SLOT); float* GATE = (float*)(F.ws + WS_GATE); int* TOKL = (int*)(F.ws + WS_TOKL);
    const int tok0 = bid * 128, b = bid >> 4, chunk = bid / (256 / NCH);
    LAS float* gs = (LAS float*)F.lds;
    LAS float* sh = gs + 1024;
    LAS float* rs = gs + 2048;
    LAS float* LGT = gs + 2304;
    LAS float* LGT2 = LGT + 128 * 65;
    LAS int* lcnt = (LAS int*)(gs + 2304 + 2 * 128 * 65);
    LAS int* gbase = lcnt + 64;
    LAS int* lsl = gbase + 64;
    for (int c = tid; c < DM; c += 512) { gs[c] = F.inp[I_N2G][c] * (1.0f + MODF[(size_t)b * NMOD + 4 * DM + c]); sh[c] = MODF[(size_t)b * NMOD + 3 * DM + c]; }
    if (tid < 64) lcnt[tid] = 0;
    __syncthreads();
    for (int r0 = wave; r0 < 128; r0 += 32) {
        u32x4 raw[4][2];
#pragma unroll
        for (int q = 0; q < 4; ++q) { const GAS u32x4* xr = (const GAS u32x4*)(X1B + (size_t)(tok0 + r0 + 8 * q) * DM) + lane; raw[q][0] = xr[0]; raw[q][1] = xr[64]; }
#pragma unroll
        for (int q = 0; q < 4; ++q) {
            const int r = r0 + 8 * q;
            float v[16]; float s = 0.f;
#pragma unroll
            for (int j = 0; j < 2; ++j) { const u32x4 w = raw[q][j];
                v[8 * j + 0] = bflo(w.x); v[8 * j + 1] = bfhi(w.x); v[8 * j + 2] = bflo(w.y); v[8 * j + 3] = bfhi(w.y); v[8 * j + 4] = bflo(w.z); v[8 * j + 5] = bfhi(w.z); v[8 * j + 6] = bflo(w.w); v[8 * j + 7] = bfhi(w.w); }
#pragma unroll
            for (int e = 0; e < 16; ++e) s += v[e] * v[e];
            const float rstd = __builtin_amdgcn_rsqf(wave_sum(s) * (1.f / DM) + 1e-6f);
            if (lane == 0) rs[r] = rstd;
            GAS u32x4* o8 = (GAS u32x4*)(H2 + (size_t)(tok0 + r) * DM) + lane;
#pragma unroll
            for (int j = 0; j < 2; ++j) { const int c = 8 * lane + 512 * j; const f32x4 g0 = *(const LAS f32x4*)(gs + c), g1 = *(const LAS f32x4*)(gs + c + 4), h0 = *(const LAS f32x4*)(sh + c), h1 = *(const LAS f32x4*)(sh + c + 4);
                u32x4 w; w.x = cvtpk(v[8 * j + 0] * rstd * g0.x + h0.x, v[8 * j + 1] * rstd * g0.y + h0.y); w.y = cvtpk(v[8 * j + 2] * rstd * g0.z + h0.z, v[8 * j + 3] * rstd * g0.w + h0.w);
                w.z = cvtpk(v[8 * j + 4] * rstd * g1.x + h1.x, v[8 * j + 5] * rstd * g1.y + h1.y); w.w = cvtpk(v[8 * j + 6] * rstd * g1.z + h1.z, v[8 * j + 7] * rstd * g1.w + h1.w); o8[64 * j] = w; }
        }
    }
    __syncthreads();
    {
        const int tt = wave >> 1, kh = wave & 1, i = lane & 31, hh = lane >> 5;
        const GAS bf16_t* xa = X1B + (size_t)(tok0 + tt * 32 + i) * DM + 512 * kh + 8 * hh;
        const GAS bf16_t* wh = RWT + (size_t)i * DM + 512 * kh + 8 * hh;
        const float rstd = rs[tt * 32 + i];
        f32x16 acc0, acc1;
#pragma unroll
        for (int q = 0; q < 16; ++q) { acc0[q] = 0.f; acc1[q] = 0.f; }
#pragma unroll 4
        for (int st = 0; st < 32; ++st) {
            const u32x4 xw = *(const GAS u32x4*)(xa + 16 * st);
            const bf16x8 w0h = *(const GAS bf16x8*)(wh + 16 * st), w0l = *(const GAS bf16x8*)(wh + 65536 + 16 * st), w1h = *(const GAS bf16x8*)(wh + 32 * DM + 16 * st), w1l = *(const GAS bf16x8*)(wh + 65536 + 32 * DM + 16 * st);
            const LAS float* gp = gs + 512 * kh + 16 * st + 8 * hh; const LAS float* hp = sh + 512 * kh + 16 * st + 8 * hh;
            const f32x4 g0 = *(const LAS f32x4*)gp, g1 = *(const LAS f32x4*)(gp + 4), h0 = *(const LAS f32x4*)hp, h1 = *(const LAS f32x4*)(hp + 4);
            float hv[8] = {bflo(xw.x) * rstd * g0.x + h0.x, bfhi(xw.x) * rstd * g0.y + h0.y, bflo(xw.y) * rstd * g0.z + h0.z, bfhi(xw.y) * rstd * g0.w + h0.w,
                           bflo(xw.z) * rstd * g1.x + h1.x, bfhi(xw.z) * rstd * g1.y + h1.y, bflo(xw.w) * rstd * g1.z + h1.z, bfhi(xw.w) * rstd * g1.w + h1.w};
            u32x4 ph; ph.x = cvtpk(hv[0], hv[1]); ph.y = cvtpk(hv[2], hv[3]); ph.z = cvtpk(hv[4], hv[5]); ph.w = cvtpk(hv[6], hv[7]);
            u32x4 pl; pl.x = cvtpk(hv[0] - bflo(ph.x), hv[1] - bfhi(ph.x)); pl.y = cvtpk(hv[2] - bflo(ph.y), hv[3] - bfhi(ph.y)); pl.z = cvtpk(hv[4] - bflo(ph.z), hv[5] - bfhi(ph.z)); pl.w = cvtpk(hv[6] - bflo(ph.w), hv[7] - bfhi(ph.w));
            const bf16x8 ah = __builtin_bit_cast(bf16x8, ph), al = __builtin_bit_cast(bf16x8, pl);
            acc0 = __builtin_amdgcn_mfma_f32_32x32x16_bf16(ah, w0h, acc0, 0, 0, 0); acc1 = __builtin_amdgcn_mfma_f32_32x32x16_bf16(ah, w1h, acc1, 0, 0, 0);
            acc0 = __builtin_amdgcn_mfma_f32_32x32x16_bf16(ah, w0l, acc0, 0, 0, 0); acc1 = __builtin_amdgcn_mfma_f32_32x32x16_bf16(ah, w1l, acc1, 0, 0, 0);
            acc0 = __builtin_amdgcn_mfma_f32_32x32x16_bf16(al, w0h, acc0, 0, 0, 0); acc1 = __builtin_amdgcn_mfma_f32_32x32x16_bf16(al, w1h, acc1, 0, 0, 0);
        }
        LAS float* LT = kh == 0 ? LGT : LGT2;
#pragma unroll
        for (int q = 0; q < 16; ++q) { const int trow = (q & 3) + 8 * (q >> 2) + 4 * hh; LT[(tt * 32 + trow) * 65 + i] = acc0[q]; LT[(tt * 32 + trow) * 65 + 32 + i] = acc1[q]; }
    }
    __syncthreads();
    const float rbias = F.inp[I_RB][lane];
    for (int r = wave; r < 128; r += 8) {
        const float score = sigmoidf_(LGT[r * 65 + lane] + LGT2[r * 65 + lane]);
        const float sel = score + rbias;
        const float m1 = oct_max(sel);
        const int i1 = oct_min((sel == m1) ? (lane & 7) : 99);
        const float m2 = oct_max(((lane & 7) == i1) ? -INFINITY : sel);
        const float gsc = m1 + m2;
        const int gme = lane >> 3; int rank = 0;
#pragma unroll
        for (int gq = 0; gq < 8; ++gq) { const float og = rdl(gsc, gq * 8); rank += (og > gsc || (og == gsc && gq < gme)) ? 1 : 0; }
        float msk = (rank < 4) ? sel : -INFINITY;
        bool chosen = false; int myj = 0;
#pragma unroll 1
        for (int j = 0; j < 8; ++j) {
            const float mx = wave_max(msk);
            const unsigned long long bal = __ballot(msk == mx);
            const int win = __ffsll((long long)bal) - 1;
            if (lane == win) { chosen = true; myj = j; msk = -INFINITY; }
        }
        const float gsum = wave_sum(chosen ? score : 0.f);
        if (chosen) {
            const float gate = score / gsum * 2.5f;
            const int lpos = atomicAdd((int*)&lcnt[lane], 1);
            lsl[r * 8 + myj] = lane | (lpos << 8);
            GATE[(size_t)(tok0 + r) * 8 + myj] = gate;
        }
    }
    __syncthreads();
    if (tid < 64) gbase[tid] = (int)__hip_atomic_fetch_add((unsigned*)(F.ctl + CW_GCNT) + chunk * 64 + tid, (unsigned)lcnt[tid], RLX_AGENT);
    __syncthreads();
    for (int q = tid; q < 128 * 8; q += 512) {
        const int v = lsl[q], e = v & 255, pos = gbase[e] + (v >> 8), r = q >> 3;
        TOKL[((size_t)chunk * 64 + e) * CAPE + pos] = tok0 + r;
        SLOT[(size_t)(tok0 + r) * 8 + (q & 7)] = e | (pos << 8);
    }
    __syncthreads();
}

template <int CTRL, int RMASK> __device__ __forceinline__ int dppzi(int x) { return __builtin_amdgcn_update_dpp(0, x, CTRL, RMASK, 0xf, false); }
__device__ __forceinline__ void moe_tables(Frame& F, int chunk, LAS int* tb) {
    if (F.tid < 64) {
        const int cnt = (int)__hip_atomic_load((unsigned*)(F.ctl + CW_GCNT) + chunk * 64 + F.tid, RLX_AGENT);
        const int nb = (cnt + 255) >> 8; int x = nb;
        x += dppzi<0x111, 0xf>(x); x += dppzi<0x112, 0xf>(x); x += dppzi<0x114, 0xf>(x); x += dppzi<0x118, 0xf>(x); x += dppzi<0x142, 0xa>(x); x += dppzi<0x143, 0xc>(x);
        tb[F.tid] = cnt; tb[72 + F.tid] = (x - nb) * 256; tb[144 + F.tid] = x - nb;
        if (F.tid == 63) { constexpr int nb64 = (TCH + 255) >> 8; tb[64] = TCH; tb[72 + 64] = x * 256; tb[144 + 64] = x; tb[72 + 65] = (x + nb64) * 256; tb[144 + 65] = x + nb64; }
    }
    __syncthreads();
}
__device__ __forceinline__ int moe_units(Frame& F, int chunk, int npn, bool g1, LAS int* tb, LAS int* ul) {
    const int nblk = tb[144 + 65], nun = nblk * npn;
    const int G = F.G, c = F.bid;
    const int n = (nun > c) ? (nun - c + G - 1) / G : 0;
    if (F.tid < n) {
        int wg = F.tid * G + c;
        { const int q = nun / 8, r = nun % 8, xcd = wg % 8, off = wg / 8; wg = (xcd < r ? xcd * (q + 1) : r * (q + 1) + (xcd - r) * q) + off; }
        const int bg = wg / npn, pn = wg % npn;
        int e = 0;
#pragma unroll
        for (int st = 64; st >= 1; st >>= 1) { const int t = e + st; if (t <= 64 && tb[144 + t] <= bg) e = t; }
        const int blk = bg - tb[144 + e], cnt = tb[e], nvalid = min(256, cnt - blk * 256), orow = tb[72 + e] + blk * 256;
        LAS int* p = ul + F.tid * 8;
        if (g1) { p[0] = chunk * TCH + blk * 256; p[1] = e * 512 + pn * 256; p[2] = (e < 64) ? ((chunk * 64 + e) * CAPE + blk * 256) : -1; p[3] = nvalid; p[4] = orow; p[5] = pn; p[6] = e; p[7] = 0; }
        else { p[0] = orow; p[1] = e * 1024 + pn * 256; p[2] = 0; p[3] = 256; p[4] = orow; p[5] = pn; p[6] = e; p[7] = 0; }
    }
    __syncthreads();
    return n;
}
__device__ __forceinline__ void combine_chunk(Frame& F, int chunk, LAS int* tb) {
    LAUNDER(F);
    const int lane = F.lane, wave = F.wave;
    const GAS unsigned char* Y = (const GAS unsigned char*)(F.ws + WS_Y);
    const GAS int* SLOT = (const GAS int*)(F.ws + WS_SLOT); const GAS float* GATE = (const GAS float*)(F.ws + WS_GATE); const GAS float* MODF = (const GAS float*)(F.ws + WS_MODF);
    const GAS bf16_t* X1B = (const GAS bf16_t*)(F.ws + WS_X1B); GAS float* OUT = (GAS float*)F.out;
    float pscale = 1.0f;
    if (PROBE_K >= 0 && chunk == NCH - 1) { const unsigned long long* ts = (const unsigned long long*)(F.ctl + CW_TS); const float tus = (float)(ts[PROBE_K + 1] - ts[PROBE_K]) * 0.01f; pscale = 1.0f + sqrtf(tus * 1e-3f); }
    constexpr int TPW = TCH / 256;
    static_assert(TPW == 64, "combine mapping");
    const int tokb = chunk * TCH + F.bid * TPW;
    const int tokL = tokb + wave + 8 * (lane >> 3);
    const int sv = SLOT[(size_t)tokL * 8 + (lane & 7)]; const float gvL = GATE[(size_t)tokL * 8 + (lane & 7)];
    const int rowL = tb[72 + (sv & 255)] + (sv >> 8);
    const int shrow = tb[72 + 64] + (tokb - chunk * TCH) + wave;
    const GAS f32x4* fg = (const GAS f32x4*)F.inp[I_FNG] + 4 * lane;
    const f32x4 fgv[4] = {fg[0], fg[1], fg[2], fg[3]};
    const GAS f32x4* g2p = (const GAS f32x4*)(MODF + (size_t)(tokb >> 11) * NMOD + 5 * DM + 16 * lane);
    const f32x4 g2v[4] = {g2p[0], g2p[1], g2p[2], g2p[3]};
    u32x4 yA[9], yB[9], xA0, xA1, xB0, xB1;
    LAS f32x4* ob = (LAS f32x4*)(F.lds + wave * 4096);
#define CB_LOAD(i_, yw, x0, x1) do { const int ii_ = (i_) < 8 ? (i_) : 7; \
        _Pragma("unroll") for (int j = 0; j < 8; ++j) { const int rowi = __builtin_amdgcn_readlane(rowL, 8 * ii_ + j); yw[j] = *(const GAS u32x4*)(Y + (size_t)rowi * DM + 16 * lane); } \
        yw[8] = *(const GAS u32x4*)(Y + (size_t)(shrow + 8 * ii_) * DM + 16 * lane); \
        const GAS bf16_t* xp_ = X1B + (size_t)(tokb + wave + 8 * ii_) * DM + 16 * lane; x0 = *(const GAS u32x4*)xp_; x1 = *(const GAS u32x4*)(xp_ + 8); } while (0)
#define CB_TOKEN(i_, yw, xb0, xb1) do { const int tok = tokb + wave + 8 * (i_), b = tok >> 11; \
        float gt[9]; _Pragma("unroll") for (int j = 0; j < 8; ++j) gt[j] = __builtin_bit_cast(float, __builtin_amdgcn_readlane(__builtin_bit_cast(int, gvL), 8 * (i_) + j)); gt[8] = 1.0f; \
        GAS f32x4* xr = (GAS f32x4*)(OUT + (size_t)tok * DM + 16 * lane); \
        const f32x4 xv[4] = {{bflo(xb0.x), bfhi(xb0.x), bflo(xb0.y), bfhi(xb0.y)}, {bflo(xb0.z), bfhi(xb0.z), bflo(xb0.w), bfhi(xb0.w)}, {bflo(xb1.x), bfhi(xb1.x), bflo(xb1.y), bfhi(xb1.y)}, {bflo(xb1.z), bfhi(xb1.z), bflo(xb1.w), bfhi(xb1.w)}}; \
        f32x4 acc[4]; \
        _Pragma("unroll") for (int q = 0; q < 4; ++q) acc[q] = (f32x4){0.f, 0.f, 0.f, 0.f}; \
        _Pragma("unroll") for (int j = 0; j < 9; ++j) { \
            const unsigned ww[4] = {yw[j].x, yw[j].y, yw[j].z, yw[j].w}; \
            _Pragma("unroll") for (int q = 0; q < 4; ++q) { const f32x2 lo = __builtin_amdgcn_cvt_pk_f32_fp8((int)ww[q], false), hi = __builtin_amdgcn_cvt_pk_f32_fp8((int)ww[q], true); \
                acc[q].x += gt[j] * lo.x; acc[q].y += gt[j] * lo.y; acc[q].z += gt[j] * hi.x; acc[q].w += gt[j] * hi.y; } } \
        f32x4 v[4]; float s = 0.f; \
        _Pragma("unroll") for (int q = 0; q < 4; ++q) { v[q] = xv[q] + g2v[q] * acc[q]; s += (v[q].x * v[q].x + v[q].y * v[q].y) + (v[q].z * v[q].z + v[q].w * v[q].w); } \
        const float rstd = __builtin_amdgcn_rsqf(wave_sum(s) * (1.f / DM) + 1e-6f); \
          \
        _Pragma("unroll") for (int q = 0; q < 4; ++q) ob[4 * lane + q] = v[q] * (rstd * pscale) * fgv[q]; \
        xr = (GAS f32x4*)(OUT + (size_t)tok * DM) + lane; \
        _Pragma("unroll") for (int q = 0; q < 4; ++q) xr[64 * q] = ob[64 * q + lane]; } while (0)
    CB_LOAD(0, yA, xA0, xA1); CB_LOAD(1, yB, xB0, xB1);
#pragma unroll 1
    for (int i2 = 0; i2 < 8; i2 += 2) {
        CB_TOKEN(i2, yA, xA0, xA1); CB_LOAD(i2 + 2, yA, xA0, xA1);
        CB_TOKEN(i2 + 1, yB, xB0, xB1); CB_LOAD(i2 + 3, yB, xB0, xB1);
    }
#undef CB_LOAD
#undef CB_TOKEN
}

constexpr int NPHASE = 8 + 2 * NCH;
struct Args { const float* in[32]; float* out; unsigned char* ws; int ph_lo, ph_hi, li, pad; };
__global__ void __launch_bounds__(512, 2) fwd_kernel(Args args) {
    extern __shared__ __attribute__((aligned(16))) unsigned char lds[];
    Frame F;
    F.lds = (LAS unsigned char*)lds;
    F.MISC = (volatile LAS unsigned*)(F.lds + MISC_OFF);
    F.tid = threadIdx.x; F.lane = F.tid & 63; F.wave = __builtin_amdgcn_readfirstlane(F.tid >> 6);
    F.G = gridDim.x; F.bid = blockIdx.x;
    F.inp = (const gcf __attribute__((address_space(4)))*)__builtin_amdgcn_kernarg_segment_ptr();
    F.out = args.out; F.ws = args.ws;
    F.ctl = (gu32*)(args.ws + WS_CTL);
    for (int u = F.tid; u < (LDS_BYTES - LDSCTL_OFF) / 4; u += 512) ((LAS unsigned*)(F.lds + LDSCTL_OFF))[u] = 0u;
    __syncthreads();
    XcdBarrier bar; bar.bar = (unsigned*)(F.ctl + CW_BAR); bar.x = 0; bar.st = nullptr;
    if (MK_N_LAUNCHES == 1) bar = xcd_barrier_post((unsigned*)(F.ctl + CW_BAR), F.MISC + 8);
    const int lo = args.ph_lo, hi = args.ph_hi;
    LAS int* tb = (LAS int*)(F.lds + TBL_OFF);
    LAS int* ul = tb + 256;
#ifndef PH_MASK
#define PH_MASK 0xFFFF
#endif
    int dup = 0;
    const int wave_s = __builtin_amdgcn_readfirstlane((int)threadIdx.x >> 6);
#pragma unroll 1
    for (int ph = lo; ph < hi; ++ph) {
        LAUNDER(F); F.dup = dup;
        { int tid_ = wave_s * 64 + (int)__builtin_amdgcn_mbcnt_hi(~0u, __builtin_amdgcn_mbcnt_lo(~0u, 0u)); asm volatile("" : "+v"(tid_)); F.tid = tid_; F.lane = tid_ & 63; F.wave = wave_s;
          int bid_ = blockIdx.x, g_ = gridDim.x; asm volatile("" : "+s"(bid_), "+s"(g_)); F.bid = bid_; F.G = g_; }
        const int phm = ph;
        if (PROBE_K >= 0 && F.bid == 0 && F.tid == 0) { ((unsigned long long*)(F.ctl + CW_TS))[ph] = __builtin_amdgcn_s_memrealtime(); }
#define PHB(k) ((PH_MASK >> (k)) & 1)
        if (phm == 0 && PHB(0)) { p0a(F); }
        else if (phm == 1 && PHB(1)) { p0b(F); }
        else if (phm == 2 && PHB(2)) {
            pg8::Gemm g{(const bf16_t*)F.out, (const bf16_t*)(F.ws + WS_WIN), nullptr, DM, DM}; pg8::InProjOrder S; S.init(F.G, F.bid);
            pg8::EpiCols E{(GAS bf16_t*)(F.ws + WS_CRW), (GAS bf16_t*)(F.ws + WS_CHG)};
            pg8::gemm_phase<pg8::EpiCols, pg8::InProjOrder, false, true>(F.lds, g, S, E, F.tid);
        }
        else if (phm == 3 && PHB(3)) {
#pragma unroll 1
            for (int u = F.bid; u < 256; u += F.G) { if (!(F.dup && (DUP_MODE == 2 || DUP_MODE >= 9))) rwkv_unit(F, u >> 4, (u >> 1) & 7, u & 1); if (!(F.dup && DUP_MODE != 0 && DUP_MODE != 2 && DUP_MODE < 9)) hgrn_unit(F, u >> 4, (u >> 1) & 7, u & 1); }
        }
        else if (phm == 4 && PHB(4)) {
            post_phase(F);
        }
        else if (phm == 5 && PHB(5)) {
            pg8::Gemm g{(const bf16_t*)(F.ws + WS_CRW), (const bf16_t*)(F.ws + WS_WOUT), nullptr, LD_RW, DM}; pg8::StaticOrder S; S.init(NT, DM, F.G, F.bid);
            pg8::EpiX1 E{F.inp[I_X], (gcf)(F.ws + WS_MODF), (GAS bf16_t*)(F.ws + WS_X1B)};
            pg8::gemm_phase<pg8::EpiX1, pg8::StaticOrder, false, true>(F.lds, g, S, E, F.tid);
        }
        else if (phm == 6 && PHB(6)) { route_phase(F); }
        else if (phm >= 7) {
            const bool odd = (phm & 1) != 0;
            if (odd && phm >= 9 && PHB(9)) {
                const int c = (phm - 9) >> 1;
                __syncthreads();
                if (MK_N_LAUNCHES != 1) moe_tables(F, c, tb);
                combine_chunk(F, c, tb);
                __syncthreads();
            }
            if (odd && phm <= 5 + 2 * NCH && PHB(7)) {
                const int c = (phm - 7) >> 1;
                LAUNDER(F);
                __syncthreads();
                moe_tables(F, c, tb);
                const int n = moe_units(F, c, 2, true, tb, ul);
                pg8::Gemm g{(const bf16_t*)(F.ws + WS_H2), (const bf16_t*)(F.ws + WS_W1E), (const int*)(F.ws + WS_TOKL), DM, DM};
                pg8::ListOrder S{ul, n}; pg8::EpiSwiglu E{(GAS bf16_t*)(F.ws + WS_ACT)};
                pg8::gemm_phase<pg8::EpiSwiglu, pg8::ListOrder, true, true>(F.lds, g, S, E, F.tid);
            }
            if (!odd && PHB(8)) {
                const int c = (phm - 8) >> 1;
                __syncthreads();
                if (MK_N_LAUNCHES != 1) moe_tables(F, c, tb);
                const int n = moe_units(F, c, 4, false, tb, ul);
                pg8::Gemm g{(const bf16_t*)(F.ws + WS_ACT), (const bf16_t*)(F.ws + WS_W2E), nullptr, 256, 256};
                pg8::ListOrder S{ul, n}; pg8::EpiFp8 E{(GAS unsigned char*)(F.ws + WS_Y)};
                pg8::gemm_phase<pg8::EpiFp8, pg8::ListOrder, false, true>(F.lds, g, S, E, F.tid);
            }
        }
        if (ph + 1 < hi) xcd_barrier(bar);
        if (DUP_PH >= 0 && ph == DUP_PH && dup == 0) { dup = 1; --ph; }
    }
}

extern "C" void kernel_launch(void* const* d_in, const int* in_sizes, int n_in, void* d_out, int out_size, void* d_ws, size_t ws_size, hipStream_t stream) {
    static int grid = 0;
    if (grid == 0) {
        if (n_in != 32 || out_size != NT * DM || ws_size < WS_END) { fprintf(stderr, "kernel_launch: unexpected shapes: n_in %d out %d ws %zu\n", n_in, out_size, ws_size); grid = -1; return; }
        int dev = 0, cus = 0, per_cu = 0;
        if (hipGetDevice(&dev) != hipSuccess || hipDeviceGetAttribute(&cus, hipDeviceAttributeMultiprocessorCount, dev) != hipSuccess) { grid = -1; return; }
        if (hipFuncSetAttribute((const void*)fwd_kernel, hipFuncAttributeMaxDynamicSharedMemorySize, LDS_BYTES) != hipSuccess) { fprintf(stderr, "kernel_launch: hipFuncSetAttribute failed\n"); grid = -1; return; }
        if (hipOccupancyMaxActiveBlocksPerMultiprocessor(&per_cu, (const void*)fwd_kernel, 512, LDS_BYTES) != hipSuccess || per_cu < 1)
            fprintf(stderr, "kernel_launch: occupancy query reports %d workgroups per CU\n", per_cu);
        (void)hipGetLastError();
        grid = cus;
        if (grid != 256) fprintf(stderr, "kernel_launch: %d CUs (built for 256)\n", grid);
    }
    if (grid < 0) return;
    if (hipMemsetAsync((char*)d_ws + WS_CTL, 0, CTL_ZERO_BYTES, stream) != hipSuccess) { fprintf(stderr, "kernel_launch: memset failed\n"); return; }
    Args a{};
    for (int i = 0; i < 32; ++i) a.in[i] = (const float*)d_in[i];
    a.out = (float*)d_out; a.ws = (unsigned char*)d_ws;
    if (MK_N_LAUNCHES == 1) {
        a.ph_lo = 0; a.ph_hi = NPHASE; a.li = 0;
        hipLaunchKernelGGL(fwd_kernel, dim3(grid), dim3(512), LDS_BYTES, stream, a);
    } else {
        for (int p = 0; p < NPHASE; ++p) { a.ph_lo = p; a.ph_hi = p + 1; a.li = p; hipLaunchKernelGGL(fwd_kernel, dim3(grid), dim3(512), LDS_BYTES, stream, a); }
    }
    const hipError_t le = hipPeekAtLastError();
    if (le != hipSuccess) fprintf(stderr, "kernel_launch: launch failed: %s\n", hipGetErrorName(le));
}
```
